# Optimizing an MI355X kernel written in HIP

```python
import jax, jax.numpy as jnp
from jax import lax
import numpy as np

D_MODEL = 1024
BATCH = 8
SEQ = 2048
DEPTH = 4

CTX_LEN = 256
GRID_W = 64
EXPAND = 2
D_INNER = EXPAND * D_MODEL
D_FOURIER = D_INNER // 4
FOURIER_GROUP = 64
N_FOURIER_GROUPS = D_FOURIER // FOURIER_GROUP
D_SSD = D_INNER - D_FOURIER
SSD_HEAD_DIM = 64
N_SSD_HEADS = D_SSD // SSD_HEAD_DIM
N_BC_GROUPS = 4
HEADS_PER_GROUP = N_SSD_HEADS // N_BC_GROUPS
D_STATE = 128
CONV_K = 3
CONV_CH = D_SSD + 2 * N_BC_GROUPS * D_STATE
CHUNK = 128
D_PROJ = 2 * D_FOURIER + D_SSD + CONV_CH + 2 * N_SSD_HEADS
PROJ_SPLITS = (D_FOURIER, 2 * D_FOURIER, 2 * D_FOURIER + D_SSD, 2 * D_FOURIER + D_SSD + CONV_CH)
EPS = 1e-6

kernel_name = "hybrid_fourier_ssd_prefix_dit"


def rmsnorm(x, w):
    xf = x.astype(jnp.float32)
    xf = xf * lax.rsqrt(jnp.mean(xf * xf, axis=-1, keepdims=True) + EPS)
    return xf.astype(x.dtype) * w


def segsum(a):
    cum = jnp.cumsum(a, axis=-1)
    diff = cum[..., :, None] - cum[..., None, :]
    t = a.shape[-1]
    mask = jnp.tril(jnp.ones((t, t), dtype=bool))
    return jnp.where(mask, diff, -jnp.inf)


def ssd_chunked(x, dt, A, B, C, h0):
    bsz, length, g, r, p = x.shape
    n = B.shape[-1]
    nc = length // CHUNK
    xc = (x * dt[..., None]).reshape(bsz, nc, CHUNK, g, r, p)
    bc = B.reshape(bsz, nc, CHUNK, g, n)
    cc = C.reshape(bsz, nc, CHUNK, g, n)
    a = (dt * A).reshape(bsz, nc, CHUNK, g, r).transpose(0, 3, 4, 1, 2)
    a_cum = jnp.cumsum(a, axis=-1)
    lmat = jnp.exp(segsum(a))
    cb = jnp.einsum('bclgn,bcsgn->bgcls', cc, bc)
    y_diag = jnp.einsum('bgcls,bgrcls,bcsgrp->bclgrp', cb, lmat, xc)
    decay_states = jnp.exp(a_cum[..., -1:] - a_cum)
    states = jnp.einsum('bcsgn,bgrcs,bcsgrp->bcgrpn', bc, decay_states, xc)
    states = jnp.concatenate([h0[:, None], states], axis=1)
    chunk_a = jnp.pad(a_cum[..., -1], ((0, 0), (0, 0), (0, 0), (1, 0)))
    decay_chunk = jnp.exp(segsum(chunk_a))
    new_states = jnp.einsum('bgrzc,bcgrpn->bzgrpn', decay_chunk, states)
    prev_states, h_final = new_states[:, :-1], new_states[:, -1]
    y_off = jnp.einsum('bclgn,bcgrpn,bgrcl->bclgrp', cc, prev_states, jnp.exp(a_cum))
    y = (y_diag + y_off).reshape(bsz, length, g, r, p)
    return y, h_final


def depthwise_conv_grid(u, w, bias, rows, cols):
    bsz, length, ch = u.shape
    img = u.reshape(bsz, rows, cols, ch)
    out = lax.conv_general_dilated(img, w[:, :, None, :], window_strides=(1, 1), padding='SAME',
                                   dimension_numbers=('NHWC', 'HWIO', 'NHWC'), feature_group_count=ch)
    return jax.nn.silu(out.reshape(bsz, length, ch) + bias)


def fourier_mixer(u, zf, w_f, b_f):
    bsz, length, _ = u.shape
    uf = u.astype(jnp.float32).reshape(bsz, length, N_FOURIER_GROUPS, FOURIER_GROUP)
    mixed = jnp.fft.fft2(uf, axes=(1, 3), norm='ortho').real.reshape(bsz, length, D_FOURIER)
    mixed = mixed.astype(u.dtype) @ w_f + b_f
    return mixed * jax.nn.silu(zf)


def ssd_mixer(xbc, dt_raw, zs, dt_bias, a_log, d_skip, norm_w, h0_f, h0_b):
    bsz, length, _ = xbc.shape
    f32 = jnp.float32
    g, r, p, n = N_BC_GROUPS, HEADS_PER_GROUP, SSD_HEAD_DIM, D_STATE
    xs, bm, cm = jnp.split(xbc.astype(f32), [D_SSD, D_SSD + g * n], axis=-1)
    xs = xs.reshape(bsz, length, g, r, p)
    bm = bm.reshape(bsz, length, g, n)
    cm = cm.reshape(bsz, length, g, n)
    dt = jax.nn.softplus(dt_raw.astype(f32).reshape(bsz, length, 2, N_SSD_HEADS) + dt_bias.astype(f32))
    A = -jnp.exp(a_log.astype(f32)).reshape(2, g, r)
    dt_f = dt[:, :, 0].reshape(bsz, length, g, r)
    dt_b = dt[:, :, 1].reshape(bsz, length, g, r)
    flip = lambda t: jnp.flip(t, axis=1)
    y_f, h_f = ssd_chunked(xs, dt_f, A[0], bm, cm, h0_f)
    y_b, h_b = ssd_chunked(flip(xs), flip(dt_b), A[1], flip(bm), flip(cm), h0_b)
    y = y_f + flip(y_b) + d_skip.astype(f32).reshape(g, r)[:, :, None] * xs
    gated = y.reshape(bsz, length, g, r * p) * jax.nn.silu(zs.astype(f32)).reshape(bsz, length, g, r * p)
    gated = gated * lax.rsqrt(jnp.mean(gated * gated, axis=-1, keepdims=True) + EPS)
    out = gated.reshape(bsz, length, D_SSD).astype(zs.dtype) * norm_w
    return out, h_f, h_b


def token_mixer(h, rows, cols, w_in, conv_w, conv_b, dt_bias, a_log, d_skip, ssd_norm_w,
                w_fourier, b_fourier, h0_f, h0_b):
    u, zf, zs, xbc, dt_raw = jnp.split(h @ w_in, PROJ_SPLITS, axis=-1)
    four = fourier_mixer(u, zf, w_fourier, b_fourier)
    xbc = depthwise_conv_grid(xbc, conv_w, conv_b, rows, cols)
    ssd, h_f, h_b = ssd_mixer(xbc, dt_raw, zs, dt_bias, a_log, d_skip, ssd_norm_w, h0_f, h0_b)
    return jnp.concatenate([four, ssd], axis=-1), h_f, h_b


def setup_inputs(seed: int = 0) -> dict:
    key = jax.random.key(seed)
    ks = jax.random.split(key, 20)
    f32 = jnp.float32
    nrm = lambda k, shape, s: jax.random.normal(k, shape, f32) * s
    dt0 = jnp.exp(jax.random.uniform(ks[9], (DEPTH, 2, N_SSD_HEADS), f32,
                                     minval=np.log(1e-3), maxval=np.log(1e-1)))
    return {
        "x": nrm(ks[0], (BATCH, SEQ, D_MODEL), 1.0),
        "c": nrm(ks[1], (BATCH, D_MODEL), 1.0),
        "ctx": nrm(ks[2], (BATCH, CTX_LEN, D_MODEL), 1.0),
        "c_ctx": nrm(ks[3], (D_MODEL,), 1.0),
        "norm_w": 1.0 + nrm(ks[4], (DEPTH, D_MODEL), 0.05),
        "w_ada": nrm(ks[5], (DEPTH, D_MODEL, 3 * D_MODEL), 0.5 * D_MODEL ** -0.5),
        "b_ada": nrm(ks[6], (DEPTH, 3 * D_MODEL), 0.02),
        "w_in": nrm(ks[7], (DEPTH, D_MODEL, D_PROJ), D_MODEL ** -0.5),
        "conv_w": nrm(ks[8], (DEPTH, CONV_K, CONV_K, CONV_CH), 1.0 / CONV_K),
        "conv_b": nrm(ks[10], (DEPTH, CONV_CH), 0.02),
        "dt_bias": dt0 + jnp.log(-jnp.expm1(-dt0)),
        "a_log": jnp.log(jax.random.uniform(ks[11], (DEPTH, 2, N_SSD_HEADS), f32, minval=1.0, maxval=16.0)),
        "d_skip": 1.0 + nrm(ks[12], (DEPTH, N_SSD_HEADS), 0.1),
        "ssd_norm_w": 1.0 + nrm(ks[13], (DEPTH, D_SSD), 0.05),
        "w_fourier": nrm(ks[14], (DEPTH, D_FOURIER, D_FOURIER), D_FOURIER ** -0.5),
        "b_fourier": nrm(ks[15], (DEPTH, D_FOURIER), 0.02),
        "w_out": nrm(ks[16], (DEPTH, D_INNER, D_MODEL), D_INNER ** -0.5),
        "final_norm_w": 1.0 + nrm(ks[17], (D_MODEL,), 0.05),
    }


def reference(x, c, ctx, c_ctx, norm_w, w_ada, b_ada, w_in, conv_w, conv_b, dt_bias, a_log, d_skip,
              ssd_norm_w, w_fourier, b_fourier, w_out, final_norm_w):
    bsz, seq_len, _ = x.shape
    ctx_len = ctx.shape[1]
    rows = seq_len // GRID_W
    zeros_state = jnp.zeros((bsz, N_BC_GROUPS, HEADS_PER_GROUP, SSD_HEAD_DIM, D_STATE), jnp.float32)
    silu_c = jax.nn.silu(c)
    silu_cc = jax.nn.silu(c_ctx)
    for i in range(DEPTH):
        mod = silu_c @ w_ada[i] + b_ada[i]
        shift, scale, gate = jnp.split(mod, 3, axis=-1)
        mod_c = silu_cc @ w_ada[i] + b_ada[i]
        shift_c, scale_c, gate_c = jnp.split(mod_c, 3, axis=-1)
        layer = (w_in[i], conv_w[i], conv_b[i], dt_bias[i], a_log[i], d_skip[i], ssd_norm_w[i],
                 w_fourier[i], b_fourier[i])
        hc = rmsnorm(ctx, norm_w[i]) * (1.0 + scale_c) + shift_c
        ctx_mix, h_f, h_b = token_mixer(hc, 1, ctx_len, *layer, zeros_state, zeros_state)
        hx = rmsnorm(x, norm_w[i]) * (1.0 + scale[:, None]) + shift[:, None]
        x_mix, _, _ = token_mixer(hx, rows, GRID_W, *layer, h_f, h_b)
        x = x + gate[:, None] * (x_mix @ w_out[i])
        if i < DEPTH - 1:
            ctx = ctx + gate_c * (ctx_mix @ w_out[i])
    return rmsnorm(x, final_norm_w)
```

```cpp
#include <hip/hip_runtime.h>
#include <cstdio>
#include <cstdint>

typedef unsigned short bf16_t;
typedef short bf16x8 __attribute__((ext_vector_type(8)));
typedef float f32x4 __attribute__((ext_vector_type(4)));
typedef unsigned u32x4 __attribute__((ext_vector_type(4)));
typedef unsigned u32x2 __attribute__((ext_vector_type(2)));

constexpr int DM = 1024, NB = 8, SEQ = 2048, DEPTH = 4, CTXL = 256, GRIDW = 64;
constexpr int DF = 512, DSSD = 1536, NH = 24, NG = 4, HPG = 6, DSTATE = 128, HD = 64;
constexpr int CONVCH = 2560, DPROJ = 5168;
constexpr int MLAT = NB * SEQ, MCTX = NB * CTXL, MTOT = MLAT + MCTX;
constexpr int PJ = 4608;
constexpr int PJ_ZF = 0, PJ_ZS = 512, PJ_XS = 2048, PJ_B = 3584, PJ_C = 4096;
constexpr int N1 = 4864;
constexpr int NDT = 48;
constexpr float EPS = 1e-6f;

constexpr size_t al256(size_t x) { return (x + 255) & ~(size_t)255; }
constexpr size_t WS_CTL  = 0;
constexpr size_t WS_MOD  = 65536;
constexpr size_t WS_XC   = al256(WS_MOD + (size_t)DEPTH * 9 * 3072 * 4);
constexpr size_t WS_H    = al256(WS_XC + (size_t)MCTX * DM * 4);
constexpr size_t WS_HEXT = al256(WS_H + (size_t)MTOT * DM * 2);
constexpr size_t WS_PROJ = al256(WS_HEXT + (size_t)MTOT * DM * 2);
constexpr size_t WS_ZT   = al256(WS_PROJ + (size_t)MTOT * PJ * 2);
constexpr size_t WS_DT   = al256(WS_ZT + (size_t)MTOT * 1024 * 2);
constexpr size_t WS_W1   = al256(WS_DT + (size_t)MTOT * NDT * 4);
constexpr size_t WS_WZ   = al256(WS_W1 + (size_t)N1 * DM * 2);
constexpr size_t WS_WO   = al256(WS_WZ + (size_t)1024 * DM * 2);
constexpr size_t WS_WF   = al256(WS_WO + (size_t)DM * 2048 * 2);
constexpr size_t WS_DFT  = al256(WS_WF + (size_t)512 * 512 * 2);
constexpr size_t WS_DFTC = al256(WS_DFT + (size_t)2048 * 4096 * 2);
constexpr size_t WS_END  = al256(WS_DFTC + (size_t)256 * 512 * 2);

struct Params {
    const float *x, *c, *ctx, *c_ctx, *norm_w, *w_ada, *b_ada, *w_in, *conv_w, *conv_b, *dt_bias, *a_log, *d_skip, *ssd_norm_w, *w_fourier, *b_fourier, *w_out, *final_norm_w;
    float* out; unsigned char* ws;
};

__device__ __forceinline__ unsigned f2bf(float f) { unsigned u = __builtin_bit_cast(unsigned, f); return (u + 0x7fffu + ((u >> 16) & 1u)) >> 16; }
__device__ __forceinline__ float bf2f(unsigned h) { return __builtin_bit_cast(float, h << 16); }
__device__ __forceinline__ unsigned pk2(float lo, float hi) { return f2bf(lo) | (f2bf(hi) << 16); }
__device__ __forceinline__ float silu_f(float v) { return v / (1.f + __expf(-v)); }
__device__ __forceinline__ float softplus_f(float v) { return v > 20.f ? v : log1pf(__expf(v)); }
__device__ __forceinline__ float wave_sum(float v) {
#pragma unroll
    for (int o = 1; o < 64; o <<= 1) v += __shfl_xor(v, o);
    return v;
}

__global__ void __launch_bounds__(256) k_mod(Params p) {
    __shared__ float s[9][DM];
    for (int e = threadIdx.x; e < 9 * DM; e += 256) { const int r = e / DM, k = e % DM; const float v = r < 8 ? p.c[r * DM + k] : p.c_ctx[k]; s[r][k] = silu_f(v); }
    __syncthreads();
    const int gid = blockIdx.x * 256 + threadIdx.x;
    if (gid >= DEPTH * 3072) return;
    const int i = gid / 3072, j = gid % 3072;
    float acc[9];
#pragma unroll
    for (int r = 0; r < 9; ++r) acc[r] = 0.f;
    const float* w = p.w_ada + (size_t)i * DM * 3072 + j;
    for (int k = 0; k < DM; ++k) { const float wv = w[(size_t)k * 3072];
#pragma unroll
        for (int r = 0; r < 9; ++r) acc[r] += s[r][k] * wv; }
    float* mod = (float*)(p.ws + WS_MOD);
    const float b = p.b_ada[i * 3072 + j];
#pragma unroll
    for (int r = 0; r < 9; ++r) mod[((size_t)i * 9 + r) * 3072 + j] = acc[r] + b;
}

__device__ void transpose_tile(const float* src, int ldn, int c0, int nvalid, bf16_t* dst, int K, int tk, int tn, float (*t)[65]) {
    const int tid = threadIdx.x;
    for (int e = tid; e < 64 * 64; e += 256) { const int kk = e / 64, nn = e % 64; const int n = tn * 64 + nn;
        t[kk][nn] = (n < nvalid) ? src[(size_t)(tk * 64 + kk) * ldn + c0 + n] : 0.f; }
    __syncthreads();
    for (int e = tid; e < 64 * 32; e += 256) { const int nn = e / 32, k2 = (e % 32) * 2; const int n = tn * 64 + nn;
        *(unsigned*)(dst + (size_t)n * K + tk * 64 + k2) = pk2(t[k2][nn], t[k2 + 1][nn]); }
    __syncthreads();
}
__global__ void __launch_bounds__(256) k_convert(Params p, int layer) {
    __shared__ float t[64][65];
    __shared__ float cs[64], sn[64];
    const float* w_in = p.w_in + (size_t)layer * DM * DPROJ;
    const float* w_out = p.w_out + (size_t)layer * 2048 * DM;
    const float* w_f = p.w_fourier + (size_t)layer * 512 * 512;
    bf16_t* W1 = (bf16_t*)(p.ws + WS_W1); bf16_t* WZ = (bf16_t*)(p.ws + WS_WZ); bf16_t* WO = (bf16_t*)(p.ws + WS_WO); bf16_t* WF = (bf16_t*)(p.ws + WS_WF);
    if (threadIdx.x < 64) { cs[threadIdx.x] = cospif(2.f * threadIdx.x / 64.f); sn[threadIdx.x] = sinpif(2.f * threadIdx.x / 64.f); }
    __syncthreads();
    constexpr int T1 = (DM / 64) * (N1 / 64), TO = (2048 / 64) * (DM / 64), TF = (512 / 64) * (512 / 64), TZ = (DM / 64) * 8;
    for (int it = blockIdx.x; it < T1 + TO + TF + TZ; it += gridDim.x) {
        int r = it;
        if (r < T1) { transpose_tile(w_in, DPROJ, 512, PJ + NDT, W1, DM, r / (N1 / 64), r % (N1 / 64), t); continue; } r -= T1;
        if (r < TO) { transpose_tile(w_out, DM, 0, DM, WO, 2048, r / (DM / 64), r % (DM / 64), t); continue; } r -= TO;
        if (r < TF) { transpose_tile(w_f, 512, 0, 512, WF, 512, r / 8, r % 8, t); continue; } r -= TF;
        { const int tk = r / 8, g = r % 8, tid = threadIdx.x;
          for (int e = tid; e < 64 * 64; e += 256) { const int kk = e / 64, cc = e % 64; t[kk][cc] = w_in[(size_t)(tk * 64 + kk) * DPROJ + g * 64 + cc]; }
          __syncthreads();
          for (int e = tid; e < 128 * 64; e += 256) { const int kk = e % 64, mm = e / 64; const int part = mm / 64, m = mm % 64;
              float acc = 0.f;
              for (int cc = 0; cc < 64; ++cc) { const int idx = (cc * m) & 63; acc += t[kk][cc] * (part ? -sn[idx] : cs[idx]); }
              WZ[(size_t)(part * 512 + g * 64 + m) * DM + tk * 64 + kk] = (bf16_t)f2bf(acc); }
          __syncthreads(); }
    }
}
__global__ void __launch_bounds__(256) k_dftgen(Params p) {
    bf16_t* D = (bf16_t*)(p.ws + WS_DFT); bf16_t* Dc = (bf16_t*)(p.ws + WS_DFTC);
    const size_t n1 = (size_t)2048 * 4096, n2 = (size_t)256 * 512;
    for (size_t e = (size_t)blockIdx.x * 256 + threadIdx.x; e < n1 + n2; e += (size_t)gridDim.x * 256) {
        if (e < n1) { const int k = (int)(e / 4096), l = (int)(e % 4096); const int ll = l & 2047; const int idx = (k * ll) & 2047; const float a = 2.f * idx / 2048.f;
            D[e] = (bf16_t)f2bf(l < 2048 ? cospif(a) : sinpif(a)); }
        else { const size_t e2 = e - n1; const int k = (int)(e2 / 512), l = (int)(e2 % 512); const int ll = l & 255; const int idx = (k * ll) & 255; const float a = 2.f * idx / 256.f;
            Dc[e2] = (bf16_t)f2bf(l < 256 ? cospif(a) : sinpif(a)); }
    }
}

__global__ void __launch_bounds__(256) k_norm(Params p, int layer) {
    const int lane = threadIdx.x & 63; const int gw = blockIdx.x * 4 + (threadIdx.x >> 6), NGW = gridDim.x * 4;
    const float* mod = (const float*)(p.ws + WS_MOD) + (size_t)layer * 9 * 3072;
    const float* nw = p.norm_w + layer * DM;
    bf16_t* H = (bf16_t*)(p.ws + WS_H);
    for (int row = gw; row < MTOT; row += NGW) {
        const float* src; int r;
        if (row < MLAT) { src = (layer == 0 ? p.x : p.out) + (size_t)row * DM; r = row / SEQ; }
        else { src = (layer == 0 ? p.ctx : (const float*)(p.ws + WS_XC)) + (size_t)(row - MLAT) * DM; r = 8; }
        const float* sh = mod + r * 3072; const float* sc = sh + 1024;
        f32x4 v[4]; float ss = 0.f;
#pragma unroll
        for (int j = 0; j < 4; ++j) { v[j] = *(const f32x4*)(src + j * 256 + lane * 4); ss += v[j].x * v[j].x + v[j].y * v[j].y + v[j].z * v[j].z + v[j].w * v[j].w; }
        const float rinv = rsqrtf(wave_sum(ss) * (1.f / DM) + EPS);
#pragma unroll
        for (int j = 0; j < 4; ++j) { const int c = j * 256 + lane * 4;
            const f32x4 w = *(const f32x4*)(nw + c), s1 = *(const f32x4*)(sc + c), s0 = *(const f32x4*)(sh + c);
            const float o0 = v[j].x * rinv * w.x * (1.f + s1.x) + s0.x, o1 = v[j].y * rinv * w.y * (1.f + s1.y) + s0.y;
            const float o2 = v[j].z * rinv * w.z * (1.f + s1.z) + s0.z, o3 = v[j].w * rinv * w.w * (1.f + s1.w) + s0.w;
            u32x2 o; o.x = pk2(o0, o1); o.y = pk2(o2, o3);
            *(u32x2*)(H + (size_t)row * DM + c) = o; }
    }
}

template <class Epi>
__global__ void __launch_bounds__(256) k_sgemm(const bf16_t* A, int lda, const bf16_t* Bt, int ldb, int K, Epi epi) {
    __shared__ __attribute__((aligned(16))) bf16_t As[64][40];
    __shared__ __attribute__((aligned(16))) bf16_t Bs[64][40];
    const int tid = threadIdx.x, lane = tid & 63, wid = tid >> 6, wr = wid >> 1, wc = wid & 1;
    const int row0 = blockIdx.y * 64, col0 = blockIdx.x * 64;
    f32x4 acc[2][2];
#pragma unroll
    for (int a = 0; a < 2; ++a)
#pragma unroll
        for (int b = 0; b < 2; ++b) acc[a][b] = (f32x4){0.f, 0.f, 0.f, 0.f};
    const int lr = tid >> 2, lc = (tid & 3) * 8;
    const bf16_t* ap = A + (size_t)(row0 + lr) * lda + lc; const bf16_t* bp = Bt + (size_t)(col0 + lr) * ldb + lc;
    for (int k0 = 0; k0 < K; k0 += 32) {
        const u32x4 av = *(const u32x4*)(ap + k0), bv = *(const u32x4*)(bp + k0);
        *(u32x4*)&As[lr][lc] = av; *(u32x4*)&Bs[lr][lc] = bv;
        __syncthreads();
        bf16x8 af[2], bfr[2];
#pragma unroll
        for (int m = 0; m < 2; ++m) af[m] = *(const bf16x8*)&As[wr * 32 + m * 16 + (lane & 15)][(lane >> 4) * 8];
#pragma unroll
        for (int n = 0; n < 2; ++n) bfr[n] = *(const bf16x8*)&Bs[wc * 32 + n * 16 + (lane & 15)][(lane >> 4) * 8];
#pragma unroll
        for (int m = 0; m < 2; ++m)
#pragma unroll
            for (int n = 0; n < 2; ++n) acc[m][n] = __builtin_amdgcn_mfma_f32_16x16x32_bf16(af[m], bfr[n], acc[m][n], 0, 0, 0);
        __syncthreads();
    }
#pragma unroll
    for (int m = 0; m < 2; ++m)
#pragma unroll
        for (int n = 0; n < 2; ++n)
#pragma unroll
            for (int j = 0; j < 4; ++j) epi(row0 + wr * 32 + m * 16 + (lane >> 4) * 4 + j, col0 + wc * 32 + n * 16 + (lane & 15), acc[m][n][j]);
}
struct EProj { bf16_t* proj; float* dt;
    __device__ void operator()(int r, int c, float v) const { if (c < PJ) proj[(size_t)r * PJ + c] = (bf16_t)f2bf(v); else if (c < PJ + NDT) dt[(size_t)r * NDT + (c - PJ)] = v; } };
struct EZt { bf16_t* zt;
    __device__ void operator()(int r, int c, float v) const { const int part = r >> 9, gc = r & 511;
        if (c < MLAT) { const int b = c / SEQ, l = c % SEQ; zt[(((size_t)b * 512 + gc) * 2 + part) * SEQ + l] = (bf16_t)f2bf(v); }
        else { const int t = c - MLAT, b = t / CTXL, l = t % CTXL; zt[(size_t)MLAT * 1024 + (((size_t)b * 512 + gc) * 2 + part) * CTXL + l] = (bf16_t)f2bf(v); } } };
struct EDft { bf16_t* mixed; int rowbase; float scale;
    __device__ void operator()(int r, int c, float v) const { mixed[(size_t)(rowbase + r) * 512 + c] = (bf16_t)f2bf(v * scale); } };
struct EFl { bf16_t* proj; const float* bias;
    __device__ void operator()(int r, int c, float v) const { bf16_t* q = proj + (size_t)r * PJ + PJ_ZF + c; const float z = bf2f(*q); *q = (bf16_t)f2bf((v + bias[c]) * silu_f(z)); } };
struct EOut { const float* xsrc; float* xdst; const float* csrc; float* cdst; const float* mod;
    __device__ void operator()(int r, int c, float v) const {
        if (r < MLAT) { const float g = mod[(r / SEQ) * 3072 + 2048 + c]; xdst[(size_t)r * DM + c] = xsrc[(size_t)r * DM + c] + g * v; }
        else { const float g = mod[8 * 3072 + 2048 + c]; const size_t o = (size_t)(r - MLAT) * DM + c; cdst[o] = csrc[o] + g * v; } } };

__global__ void __launch_bounds__(512) k_conv(Params p, int layer) {
    extern __shared__ __attribute__((aligned(16))) unsigned char smem[];
    bf16_t* proj = (bf16_t*)(p.ws + WS_PROJ);
    const float* cw = p.conv_w + (size_t)layer * 9 * CONVCH; const float* cb = p.conv_b + (size_t)layer * CONVCH;
    const int tid = threadIdx.x;
    constexpr int NCB = CONVCH / 32;
    for (int it = blockIdx.x; it < 16 * NCB; it += gridDim.x) {
        const int sq = it / NCB, cblk = it % NCB;
        int L, rows, cols, row0;
        if (sq < 8) { L = SEQ; rows = SEQ / GRIDW; cols = GRIDW; row0 = sq * SEQ; } else { L = CTXL; rows = 1; cols = CTXL; row0 = MLAT + (sq - 8) * CTXL; }
        bf16_t* base = proj + (size_t)row0 * PJ + PJ_XS + cblk * 32;
        for (int e = tid; e < L * 4; e += 512) { const int t = e >> 2, q = e & 3; *(u32x4*)(smem + t * 64 + q * 16) = *(const u32x4*)(base + (size_t)t * PJ + q * 8); }
        __syncthreads();
        const int cq = tid & 7, tl = tid >> 3;
        const int ch = cblk * 32 + cq * 4;
        float w[9][4], bias[4];
#pragma unroll
        for (int k = 0; k < 9; ++k)
#pragma unroll
            for (int j = 0; j < 4; ++j) w[k][j] = cw[k * CONVCH + ch + j];
#pragma unroll
        for (int j = 0; j < 4; ++j) bias[j] = cb[ch + j];
        for (int t = tl; t < L; t += 64) {
            const int r = t / cols, c = t % cols;
            float a0 = bias[0], a1 = bias[1], a2 = bias[2], a3 = bias[3];
#pragma unroll
            for (int i = 0; i < 3; ++i) { const int rr = r + i - 1; if (rr < 0 || rr >= rows) continue;
#pragma unroll
                for (int j = 0; j < 3; ++j) { const int c2 = c + j - 1; if (c2 < 0 || c2 >= cols) continue;
                    const u32x2 v = *(const u32x2*)(smem + (rr * cols + c2) * 64 + cq * 8);
                    a0 += w[i * 3 + j][0] * bf2f(v.x & 0xffffu); a1 += w[i * 3 + j][1] * bf2f(v.x >> 16);
                    a2 += w[i * 3 + j][2] * bf2f(v.y & 0xffffu); a3 += w[i * 3 + j][3] * bf2f(v.y >> 16); } }
            u32x2 o; o.x = pk2(silu_f(a0), silu_f(a1)); o.y = pk2(silu_f(a2), silu_f(a3));
            *(u32x2*)(base + (size_t)t * PJ + cq * 4) = o;
        }
        __syncthreads();
    }
}

__global__ void __launch_bounds__(64) k_ssd_naive(Params p, int layer) {
    __shared__ float yf[CTXL + SEQ];
    const int lane = threadIdx.x;
    const int pp = blockIdx.x % HD, head = (blockIdx.x / HD) % NH, b = blockIdx.x / (HD * NH);
    const int g = head / HPG;
    bf16_t* proj = (bf16_t*)(p.ws + WS_PROJ); const float* dtb = (const float*)(p.ws + WS_DT);
    const float dsk = p.d_skip[layer * NH + head];
    for (int dir = 0; dir < 2; ++dir) {
        const float A = -__expf(p.a_log[(layer * 2 + dir) * NH + head]); const float bias = p.dt_bias[(layer * 2 + dir) * NH + head];
        float h0 = 0.f, h1 = 0.f;
        for (int s = 0; s < CTXL + SEQ; ++s) {
            int row, slot;
            if (dir == 0) { if (s < CTXL) { row = MLAT + b * CTXL + s; slot = s; } else { row = b * SEQ + (s - CTXL); slot = s; } }
            else { if (s < CTXL) { const int t = CTXL - 1 - s; row = MLAT + b * CTXL + t; slot = t; } else { const int t = SEQ - 1 - (s - CTXL); row = b * SEQ + t; slot = CTXL + t; } }
            const bf16_t* pr = proj + (size_t)row * PJ;
            const float xv = bf2f(pr[PJ_XS + head * HD + pp]);
            const float B0 = bf2f(pr[PJ_B + g * DSTATE + lane]), B1 = bf2f(pr[PJ_B + g * DSTATE + 64 + lane]);
            const float C0 = bf2f(pr[PJ_C + g * DSTATE + lane]), C1 = bf2f(pr[PJ_C + g * DSTATE + 64 + lane]);
            const float dt = softplus_f(dtb[(size_t)row * NDT + dir * NH + head] + bias);
            const float a = __expf(dt * A), dx = dt * xv;
            h0 = a * h0 + dx * B0; h1 = a * h1 + dx * B1;
            const float y = wave_sum(C0 * h0 + C1 * h1);
            if (dir == 0) { if (lane == 0) yf[slot] = y; }
            else if (lane == 0) { bf16_t* q = proj + (size_t)row * PJ + PJ_ZS + head * HD + pp; const float z = bf2f(*q); *q = (bf16_t)f2bf((yf[slot] + y + dsk * xv) * silu_f(z)); }
        }
        __syncthreads();
    }
}

__global__ void __launch_bounds__(256) k_gnorm(Params p, int layer) {
    const int lane = threadIdx.x & 63; const int gw = blockIdx.x * 4 + (threadIdx.x >> 6), NGW = gridDim.x * 4;
    bf16_t* proj = (bf16_t*)(p.ws + WS_PROJ); const float* nw = p.ssd_norm_w + layer * DSSD;
    for (int it = gw; it < MTOT * NG; it += NGW) {
        const int row = it / NG, g = it % NG;
        bf16_t* q = proj + (size_t)row * PJ + PJ_ZS + g * 384;
        float v[6]; float ss = 0.f;
#pragma unroll
        for (int j = 0; j < 3; ++j) { const unsigned u = *(const unsigned*)(q + j * 128 + lane * 2); v[2 * j] = bf2f(u & 0xffffu); v[2 * j + 1] = bf2f(u >> 16); ss += v[2 * j] * v[2 * j] + v[2 * j + 1] * v[2 * j + 1]; }
        const float rinv = rsqrtf(wave_sum(ss) * (1.f / 384.f) + EPS);
#pragma unroll
        for (int j = 0; j < 3; ++j) { const int c = j * 128 + lane * 2; *(unsigned*)(q + c) = pk2(v[2 * j] * rinv * nw[g * 384 + c], v[2 * j + 1] * rinv * nw[g * 384 + c + 1]); }
    }
}

__global__ void __launch_bounds__(256) k_final(Params p) {
    const int lane = threadIdx.x & 63; const int gw = blockIdx.x * 4 + (threadIdx.x >> 6), NGW = gridDim.x * 4;
    for (int row = gw; row < MLAT; row += NGW) {
        float* src = p.out + (size_t)row * DM;
        f32x4 v[4]; float ss = 0.f;
#pragma unroll
        for (int j = 0; j < 4; ++j) { v[j] = *(const f32x4*)(src + j * 256 + lane * 4); ss += v[j].x * v[j].x + v[j].y * v[j].y + v[j].z * v[j].z + v[j].w * v[j].w; }
        const float rinv = rsqrtf(wave_sum(ss) * (1.f / DM) + EPS);
#pragma unroll
        for (int j = 0; j < 4; ++j) { const int c = j * 256 + lane * 4; const f32x4 w = *(const f32x4*)(p.final_norm_w + c);
            *(f32x4*)(src + c) = (f32x4){v[j].x * rinv * w.x, v[j].y * rinv * w.y, v[j].z * rinv * w.z, v[j].w * rinv * w.w}; }
    }
}

extern "C" void kernel_launch(void* const* d_in, const int* in_sizes, int n_in, void* d_out, int out_size, void* d_ws, size_t ws_size, hipStream_t stream) {
    if (n_in != 18 || ws_size < WS_END || out_size != MLAT * DM) { fprintf(stderr, "kernel_launch: unexpected shapes (n_in %d, ws %zu need %zu, out %d)\n", n_in, ws_size, (size_t)WS_END, out_size); return; }
    Params p{};
    const float** f = (const float**)&p;
    for (int i = 0; i < 18; ++i) f[i] = (const float*)d_in[i];
    p.out = (float*)d_out; p.ws = (unsigned char*)d_ws;
    unsigned char* ws = p.ws;
    static bool attr = false;
    if (!attr) { (void)hipFuncSetAttribute((const void*)k_conv, hipFuncAttributeMaxDynamicSharedMemorySize, 131072); attr = true; }
    bf16_t* H = (bf16_t*)(ws + WS_H); bf16_t* MIXED = H; bf16_t* PROJ = (bf16_t*)(ws + WS_PROJ); bf16_t* ZT = (bf16_t*)(ws + WS_ZT); float* DT = (float*)(ws + WS_DT);
    bf16_t* W1 = (bf16_t*)(ws + WS_W1); bf16_t* WZ = (bf16_t*)(ws + WS_WZ); bf16_t* WO = (bf16_t*)(ws + WS_WO); bf16_t* WF = (bf16_t*)(ws + WS_WF);
    bf16_t* DFT = (bf16_t*)(ws + WS_DFT); bf16_t* DFTC = (bf16_t*)(ws + WS_DFTC);
    float* XC = (float*)(ws + WS_XC); const float* MOD = (const float*)(ws + WS_MOD);

    k_mod<<<(DEPTH * 3072 + 255) / 256, 256, 0, stream>>>(p);
    k_dftgen<<<2048, 256, 0, stream>>>(p);
    for (int i = 0; i < DEPTH; ++i) {
        k_convert<<<512, 256, 0, stream>>>(p, i);
        k_norm<<<1024, 256, 0, stream>>>(p, i);
        k_sgemm<EProj><<<dim3(N1 / 64, MTOT / 64), 256, 0, stream>>>(H, DM, W1, DM, DM, EProj{PROJ, DT});
        k_sgemm<EZt><<<dim3(MTOT / 64, 1024 / 64), 256, 0, stream>>>(WZ, DM, H, DM, DM, EZt{ZT});
        k_conv<<<640, 512, 131072, stream>>>(p, i);
        for (int b = 0; b < NB; ++b) {
            k_sgemm<EDft><<<dim3(512 / 64, SEQ / 64), 256, 0, stream>>>(DFT, 4096, ZT + (size_t)b * 512 * 4096, 4096, 4096, EDft{MIXED, b * SEQ, 1.f / sqrtf(64.f * SEQ)});
            k_sgemm<EDft><<<dim3(512 / 64, CTXL / 64), 256, 0, stream>>>(DFTC, 512, ZT + (size_t)MLAT * 1024 + (size_t)b * 512 * 512, 512, 512, EDft{MIXED, MLAT + b * CTXL, 1.f / sqrtf(64.f * CTXL)});
        }
        k_ssd_naive<<<NB * NH * HD, 64, 0, stream>>>(p, i);
        k_sgemm<EFl><<<dim3(512 / 64, MTOT / 64), 256, 0, stream>>>(MIXED, 512, WF, 512, 512, EFl{PROJ, p.b_fourier + i * 512});
        k_gnorm<<<2048, 256, 0, stream>>>(p, i);
        const int mrows = (i < DEPTH - 1) ? MTOT : MLAT;
        k_sgemm<EOut><<<dim3(DM / 64, mrows / 64), 256, 0, stream>>>(PROJ, PJ, WO, 2048, 2048,
            EOut{i == 0 ? p.x : p.out, p.out, i == 0 ? p.ctx : XC, XC, MOD + (size_t)i * 9 * 3072});
    }
    k_final<<<1024, 256, 0, stream>>>(p);
}
```

```cpp
#include <hip/hip_runtime.h>
#include <hip/hip_cooperative_groups.h>
#include <cstdio>
#include <cstdint>
namespace cg = cooperative_groups;

typedef unsigned short bf16_t;
typedef short bf16x8 __attribute__((ext_vector_type(8)));
typedef float f32x4 __attribute__((ext_vector_type(4)));
typedef unsigned u32x4 __attribute__((ext_vector_type(4)));
typedef unsigned u32x2 __attribute__((ext_vector_type(2)));

constexpr int DM = 1024, NB = 8, SEQ = 2048, DEPTH = 4, CTXL = 256, GRIDW = 64;
constexpr int DF = 512, DSSD = 1536, NH = 24, NG = 4, HPG = 6, DSTATE = 128, HD = 64;
constexpr int CONVCH = 2560, DPROJ = 5168;
constexpr int MLAT = NB * SEQ, MCTX = NB * CTXL, MTOT = MLAT + MCTX;
constexpr int PJ = 4608;
constexpr int PJ_ZF = 0, PJ_ZS = 512, PJ_XS = 2048, PJ_B = 3584, PJ_C = 4096;
constexpr int N1 = 4864;
constexpr int NDT = 48;
constexpr float EPS = 1e-6f;
constexpr int NT = 512;
constexpr int LDS_BYTES = 147456 + 1024;

constexpr size_t al256(size_t x) { return (x + 255) & ~(size_t)255; }
constexpr size_t WS_CTL  = 0;
constexpr size_t WS_MOD  = 65536;
constexpr size_t WS_XC   = al256(WS_MOD + (size_t)DEPTH * 9 * 3072 * 4);
constexpr size_t WS_H    = al256(WS_XC + (size_t)MCTX * DM * 4);
constexpr size_t WS_STASH= al256(WS_H + (size_t)MTOT * DM * 2);
constexpr size_t WS_PROJ = al256(WS_STASH + (size_t)MTOT * DSSD * 2);
constexpr size_t WS_UT   = al256(WS_PROJ + (size_t)MTOT * PJ * 2);
constexpr size_t WS_DT   = al256(WS_UT + (size_t)MTOT * 512 * 2);
constexpr size_t WS_W1   = al256(WS_DT + (size_t)MTOT * NDT * 4);
constexpr size_t WS_WU   = al256(WS_W1 + (size_t)N1 * DM * 2);
constexpr size_t WS_WO   = al256(WS_WU + (size_t)512 * DM * 2);
constexpr size_t WS_WF   = al256(WS_WO + (size_t)DM * 2048 * 2);
constexpr size_t WS_DFT  = al256(WS_WF + (size_t)2 * 512 * 1024 * 2);
constexpr size_t WS_DFTC = al256(WS_DFT + (size_t)2048 * 2048 * 2);
constexpr size_t WS_RSQ  = al256(WS_DFTC + (size_t)256 * 256 * 2);
constexpr size_t WS_END  = al256(WS_RSQ + (size_t)MTOT * 4 * 4);
static_assert(WS_END <= (size_t)338690048, "workspace map exceeds 4 x the largest tensor");

struct Params {
    const float *x, *c, *ctx, *c_ctx, *norm_w, *w_ada, *b_ada, *w_in, *conv_w, *conv_b, *dt_bias, *a_log, *d_skip, *ssd_norm_w, *w_fourier, *b_fourier, *w_out, *final_norm_w;
    float* out; unsigned char* ws;
    int ph_lo, ph_hi;
    int wv;
    int fuse_final;
};

typedef __bf16 bf16v2_t __attribute__((ext_vector_type(2)));
typedef float f32x2_t __attribute__((ext_vector_type(2)));
__device__ __forceinline__ unsigned pk2(float lo, float hi) { return __builtin_bit_cast(unsigned, __builtin_convertvector((f32x2_t){lo, hi}, bf16v2_t)); }
__device__ __forceinline__ unsigned f2bf(float f) { return pk2(f, 0.f) & 0xffffu; }
__device__ __forceinline__ float bf2f(unsigned h) { return __builtin_bit_cast(float, h << 16); }
__device__ __forceinline__ float bf2f_hi(unsigned w) { return __builtin_bit_cast(float, w & 0xffff0000u); }
extern "C" __device__ float fmul1(float, float) __asm("llvm.amdgcn.fmul.legacy");
__device__ __forceinline__ float fadd1(float a, float b) { float r; asm("v_add_f32_e32 %0, %1, %2" : "=v"(r) : "v"(a), "v"(b)); return r; }
__device__ __forceinline__ float silu_f(float v) { return v * __builtin_amdgcn_rcpf(1.f + __expf(-v)); }
__device__ __forceinline__ float softplus_f(float v) { return v > 15.f ? v : __logf(1.f + __expf(v)); }
__device__ __forceinline__ int opaque_i(int x) { asm volatile("" : "+v"(x)); return x; }
__device__ __forceinline__ int lane_id() { int l; asm volatile("v_mbcnt_lo_u32_b32 %0, -1, 0\n\tv_mbcnt_hi_u32_b32 %0, -1, %0" : "=v"(l)); return l; }
__device__ __forceinline__ float shx(float v, int o, int lane) { return __int_as_float(__builtin_amdgcn_ds_bpermute((lane ^ o) << 2, __float_as_int(v))); }
__device__ __forceinline__ float shup(float v, int o, int lane) { return __int_as_float(__builtin_amdgcn_ds_bpermute((lane - o) << 2, __float_as_int(v))); }
__device__ __forceinline__ float rdl(float v, int l) { return __int_as_float(__builtin_amdgcn_readlane(__float_as_int(v), l)); }
#define ST16_WT(p_, v_) asm volatile("global_store_dwordx4 %0, %1, off sc1\n\ts_nop 1" :: "v"(p_), "v"(v_) : "memory")
#define ST8_WT(p_, v_)  asm volatile("global_store_dwordx2 %0, %1, off sc1\n\ts_nop 1" :: "v"(p_), "v"(v_) : "memory")
#define TIDX_W(wv_) opaque_i(((wv_) << 6) | lane_id())
#define TIDX TIDX_W(p.wv)
__device__ __forceinline__ float wave_sum(float v, int lane) {
#pragma unroll
    for (int o = 1; o < 64; o <<= 1) v += shx(v, o, lane);
    return v;
}

__device__ __forceinline__ void ph_mod(const Params& p, unsigned char* smem, int bid, int G) {
    float (*s)[DM] = (float (*)[DM])smem;
    float* red = (float*)(smem + 9 * DM * 4);
    const int tid = TIDX, jj = tid & 63, kq = tid >> 6;
    const int nitems = DEPTH * (3072 / 64);
    if (bid >= nitems) return;
    { float cv[18];
#pragma unroll
      for (int q = 0; q < 18; ++q) { const int e = tid + NT * q, r = e / DM, k = e % DM; cv[q] = r < 8 ? p.c[r * DM + k] : p.c_ctx[k]; }
#pragma unroll
      for (int q = 0; q < 18; ++q) { const int e = tid + NT * q; s[e / DM][e % DM] = silu_f(cv[q]); } }
    __syncthreads();
    float* mod = (float*)(p.ws + WS_MOD);
    const int lane = tid & 63, kk = lane >> 4, c4 = lane & 15;
    for (int it = bid; it < nitems; it += G) {
        const int i = it / 48;
        f32x4 acc4[9];
#pragma unroll
        for (int r = 0; r < 9; ++r) acc4[r] = (f32x4){0.f, 0.f, 0.f, 0.f};
        const int kb = kq * 128 + 32 * kk;
        const float* w = p.w_ada + ((size_t)i * DM + kb) * 3072 + (it % 48) * 64 + 4 * c4;
        for (int t0 = 0; t0 < 32; t0 += 8) {
            f32x4 wv[8];
#pragma unroll
            for (int t = 0; t < 8; ++t) wv[t] = *(const f32x4*)(w + (size_t)(t0 + t) * 3072);
#pragma unroll
            for (int r = 0; r < 9; ++r) { const f32x4 sa = *(const f32x4*)&s[r][kb + t0], sb = *(const f32x4*)&s[r][kb + t0 + 4];
                acc4[r] += wv[0] * sa.x + wv[1] * sa.y + wv[2] * sa.z + wv[3] * sa.w + wv[4] * sb.x + wv[5] * sb.y + wv[6] * sb.z + wv[7] * sb.w; } }
#pragma unroll
        for (int o = 16; o < 64; o <<= 1)
#pragma unroll
            for (int r = 0; r < 9; ++r) { acc4[r].x += shx(acc4[r].x, o, lane); acc4[r].y += shx(acc4[r].y, o, lane); acc4[r].z += shx(acc4[r].z, o, lane); acc4[r].w += shx(acc4[r].w, o, lane); }
        if (kk == 0) {
#pragma unroll
            for (int r = 0; r < 9; ++r) *(f32x4*)&red[(kq * 9 + r) * 64 + 4 * c4] = acc4[r]; }

        __syncthreads();
        for (int e = tid; e < 9 * 64; e += NT) { const int r = e / 64, c = e % 64; float v = 0.f;
#pragma unroll
            for (int q = 0; q < 8; ++q) v += red[(q * 9 + r) * 64 + c];
            const int jc = (it % 48) * 64 + c; mod[((size_t)i * 9 + r) * 3072 + jc] = v + p.b_ada[i * 3072 + jc]; }
        __syncthreads();
    }
}

__device__ __forceinline__ void ph_dftgen(const Params& p, int bid, int G) {
    bf16_t* D = (bf16_t*)(p.ws + WS_DFT); bf16_t* Dc = (bf16_t*)(p.ws + WS_DFTC);
    const size_t n1 = (size_t)2048 * 2048 / 2, n2 = (size_t)256 * 256 / 2;
    for (size_t e = (size_t)bid * NT + TIDX; e < n1 + n2; e += (size_t)G * NT) {
        if (e < n1) { const int row = (int)(e / 1024), l = (int)(e % 1024) * 2; const int k = (row & 1023) + 1;
            const float a0 = 2.f * ((k * l) & 2047) / 2048.f, a1 = 2.f * ((k * (l + 1)) & 2047) / 2048.f;
            ((unsigned*)D)[e] = row >= 1024 ? pk2(sinpif(a0), sinpif(a1)) : pk2(cospif(a0), cospif(a1)); }
        else { const size_t e2 = e - n1; const int row = (int)(e2 / 128), l = (int)(e2 % 128) * 2; const int k = (row & 127) + 1;
            const float a0 = 2.f * ((k * l) & 255) / 256.f, a1 = 2.f * ((k * (l + 1)) & 255) / 256.f;
            ((unsigned*)Dc)[e2] = row >= 128 ? pk2(sinpif(a0), sinpif(a1)) : pk2(cospif(a0), cospif(a1)); }
    }
}
__device__ __forceinline__ void ph_dft_row0(const Params& p, int cw, int ncw) {
    const int lane = TIDX & 63; const bf16_t* ut = (const bf16_t*)(p.ws + WS_UT); bf16_t* pq = (bf16_t*)(p.ws + WS_H);
    for (int it = cw * 4; it < NB * 512; it += ncw * 4) {
        u32x4 v[4][4];
#pragma unroll
        for (int u = 0; u < 4; ++u)
#pragma unroll
            for (int q = 0; q < 4; ++q) v[u][q] = *(const u32x4*)(ut + (size_t)(it + u) * SEQ + (lane + 64 * q) * 8);
        float a[4];
#pragma unroll
        for (int u = 0; u < 4; ++u) { float t = 0.f;
#pragma unroll
            for (int q = 0; q < 4; ++q) { const u32x4 w = v[u][q]; t += bf2f(w.x & 0xffffu) + bf2f_hi(w.x) + bf2f(w.y & 0xffffu) + bf2f_hi(w.y) + bf2f(w.z & 0xffffu) + bf2f_hi(w.z) + bf2f(w.w & 0xffffu) + bf2f_hi(w.w); }
            a[u] = t; }
#pragma unroll
        for (int o = 1; o < 64; o <<= 1) {
#pragma unroll
            for (int u = 0; u < 4; ++u) a[u] += shx(a[u], o, lane); }
        if (lane < 4) { const int n = it + lane; const float av = (lane == 0 ? a[0] : lane == 1 ? a[1] : lane == 2 ? a[2] : a[3]) * 0.00276213586f;
            bf16_t* q = pq + (size_t)((n >> 9) * SEQ) * 1024 + (n & 511); q[0] = (bf16_t)f2bf(av); q[512] = 0; }
    }
    for (int it = cw * 4; it < NB * 512; it += ncw * 4) {
        u32x2 v[4];
#pragma unroll
        for (int u = 0; u < 4; ++u) v[u] = *(const u32x2*)(ut + (size_t)NB * 512 * SEQ + (size_t)(it + u) * CTXL + lane * 4);
        float a[4];
#pragma unroll
        for (int u = 0; u < 4; ++u) a[u] = bf2f(v[u].x & 0xffffu) + bf2f_hi(v[u].x) + bf2f(v[u].y & 0xffffu) + bf2f_hi(v[u].y);
#pragma unroll
        for (int o = 1; o < 64; o <<= 1) {
#pragma unroll
            for (int u = 0; u < 4; ++u) a[u] += shx(a[u], o, lane); }
        if (lane < 4) { const int n = it + lane; const float av = (lane == 0 ? a[0] : lane == 1 ? a[1] : lane == 2 ? a[2] : a[3]) * 0.0078125f;
            bf16_t* q = pq + (size_t)(MLAT + (n >> 9) * CTXL) * 1024 + (n & 511); q[0] = (bf16_t)f2bf(av); q[512] = 0; }
    }
}

__device__ __forceinline__ void transpose_wide(const float* src, int ldn, int c0, int nvalid, bf16_t* dst, int K, int tk, int tn, unsigned char* smem, int wv) {
    __attribute__((address_space(3))) float* t = (__attribute__((address_space(3))) float*)((__attribute__((address_space(3))) unsigned char*)smem + 20480);
    const int tid = TIDX_W(wv);
    float v[32];
#pragma unroll
    for (int q = 0; q < 32; ++q) { const int e = tid + NT * q, kk = e >> 8, nn = e & 255, n = tn * 256 + nn; v[q] = (n < nvalid) ? src[(size_t)(tk * 64 + kk) * ldn + c0 + n] : 0.f; }
#pragma unroll
    for (int q = 0; q < 32; ++q) { const int e = tid + NT * q; t[(e >> 8) * 257 + (e & 255)] = v[q]; }
    __syncthreads();
#pragma unroll
    for (int q = 0; q < 4; ++q) { const int e = tid + NT * q, nn = e & 255, c = e >> 8;
        const __attribute__((address_space(3))) float* s = t + (8 * c) * 257 + nn;
        u32x4 o; o.x = pk2(s[0], s[257]); o.y = pk2(s[2 * 257], s[3 * 257]); o.z = pk2(s[4 * 257], s[5 * 257]); o.w = pk2(s[6 * 257], s[7 * 257]);
        *(u32x4*)(dst + (size_t)(tn * 256 + nn) * K + tk * 64 + 8 * c) = o; }
    __syncthreads();
}
__device__ __forceinline__ void ph_convert(const Params& p, unsigned char* smem, int layer, int parts, int bid, int G) {
    float (*t)[65] = (float (*)[65])smem;
    float* cs = (float*)(smem + 64 * 65 * 4); float* sn = cs + 64;
    const float* w_in = p.w_in + (size_t)layer * DM * DPROJ;
    const float* w_out = p.w_out + (size_t)layer * 2048 * DM;
    const float* w_f = p.w_fourier + (size_t)layer * 512 * 512;
    bf16_t* W1 = (bf16_t*)(p.ws + WS_W1); bf16_t* WU = (bf16_t*)(p.ws + WS_WU); bf16_t* WO = (bf16_t*)(p.ws + WS_WO); bf16_t* WF = (bf16_t*)(p.ws + WS_WF) + (size_t)(layer & 1) * 512 * 1024;
    if (bid < 0) return;
    if (TIDX < 64) { cs[TIDX] = cospif(2.f * TIDX / 64.f); sn[TIDX] = sinpif(2.f * TIDX / 64.f); }
    __syncthreads();
    constexpr int T1 = (DM / 64) * (N1 / 256), TO = (2048 / 64) * (DM / 256), TU = (DM / 64) * (512 / 256), TFp = 8 * 8;
    for (int it = bid; it < T1 + TO + TU + TFp; it += G) {
        int r = it;
        { const int cls = r < T1 ? 0 : r < T1 + TO ? 1 : r < T1 + TO + TU ? 0 : 2; if (!((parts >> cls) & 1)) continue; }
        if (r < T1) { transpose_wide(w_in, DPROJ, 512, PJ + NDT, W1, DM, r / (N1 / 256), r % (N1 / 256), smem, p.wv); continue; } r -= T1;
        if (r < TO) { transpose_wide(w_out, DM, 0, DM, WO, 2048, r / (DM / 256), r % (DM / 256), smem, p.wv); continue; } r -= TO;
        if (r < TU) { transpose_wide(w_in, DPROJ, 0, 512, WU, DM, r / 2, r % 2, smem, p.wv); continue; } r -= TU;
        { const int g = r / 8, nb = r % 8, tid = TIDX;
          { float tv[8];
#pragma unroll
            for (int q = 0; q < 8; ++q) { const int e = tid + NT * q; tv[q] = w_f[(size_t)(g * 64 + e / 64) * 512 + nb * 64 + e % 64]; }
#pragma unroll
            for (int q = 0; q < 8; ++q) { const int e = tid + NT * q; t[e / 64][e % 64] = tv[q]; } }
          __syncthreads();
          for (int e = tid; e < 64 * 64; e += NT) { const int m = e % 64, nn = e / 64;
              float ac = 0.f, as = 0.f; int idx = 0;
#pragma unroll 8
              for (int cc = 0; cc < 64; ++cc) { const float tv = t[cc][nn]; ac += tv * cs[idx]; as -= tv * sn[idx]; idx = (idx + m) & 63; }
              bf16_t* wq = WF + (size_t)(nb * 64 + nn) * 1024 + g * 64 + m; wq[0] = (bf16_t)f2bf(ac); wq[512] = (bf16_t)f2bf(as); }
          __syncthreads(); }
    }
}

__device__ __forceinline__ void ph_norm(const Params& p, int layer, int bid, int G) {
    const int tid = TIDX, lane = tid & 63; const int gw = bid * 8 + (tid >> 6), NGW = G * 8;
    const float* mod = (const float*)(p.ws + WS_MOD) + (size_t)layer * 9 * 3072;
    const float* nw = p.norm_w + layer * DM;
    bf16_t* H = (bf16_t*)(p.ws + WS_H);
    constexpr int RB = 3;
    for (int r0 = gw * RB; r0 < MTOT; r0 += NGW * RB) {
        const float* src[RB]; int rr[RB]; f32x4 v[RB][4]; float ss[RB];
#pragma unroll
        for (int u = 0; u < RB; ++u) { const int row = r0 + u;
            if (row < MLAT) { src[u] = (layer == 0 ? p.x : p.out) + (size_t)row * DM; rr[u] = row / SEQ; }
            else { src[u] = (layer == 0 ? p.ctx : (const float*)(p.ws + WS_XC)) + (size_t)(row - MLAT) * DM; rr[u] = 8; } }
#pragma unroll
        for (int u = 0; u < RB; ++u)
#pragma unroll
            for (int j = 0; j < 4; ++j) v[u][j] = *(const f32x4*)(src[u] + j * 256 + lane * 4);
#pragma unroll
        for (int u = 0; u < RB; ++u) { float a = 0.f;
#pragma unroll
            for (int j = 0; j < 4; ++j) a += v[u][j].x * v[u][j].x + v[u][j].y * v[u][j].y + v[u][j].z * v[u][j].z + v[u][j].w * v[u][j].w;
            ss[u] = a; }
#pragma unroll
        for (int o = 1; o < 64; o <<= 1) {
#pragma unroll
            for (int u = 0; u < RB; ++u) ss[u] += shx(ss[u], o, lane); }
#pragma unroll
        for (int u = 0; u < RB; ++u) { const float rinv = rsqrtf(ss[u] * (1.f / DM) + EPS); const float* sh = mod + rr[u] * 3072; const float* sc = sh + 1024;
#pragma unroll
            for (int j = 0; j < 4; ++j) { const int c = j * 256 + lane * 4;
                const f32x4 w = *(const f32x4*)(nw + c), s1 = *(const f32x4*)(sc + c), s0 = *(const f32x4*)(sh + c);
                const float o0 = v[u][j].x * rinv * w.x * (1.f + s1.x) + s0.x, o1 = v[u][j].y * rinv * w.y * (1.f + s1.y) + s0.y;
                const float o2 = v[u][j].z * rinv * w.z * (1.f + s1.z) + s0.z, o3 = v[u][j].w * rinv * w.w * (1.f + s1.w) + s0.w;
                u32x2 o; o.x = pk2(o0, o1); o.y = pk2(o2, o3);
                *(u32x2*)(H + (size_t)(r0 + u) * DM + c) = o; } }
    }
}

constexpr int CW_PANEL = 8320;
namespace pg8 {
#define PG8_LAS __attribute__((address_space(3)))
constexpr int BM = 256, BK = 64, HALF = 128, HTB = HALF * BK * 2  , STAGE_BYTES = 8 * HTB, NXCD = 8, WGM = 8;
constexpr int EPI_LDS = STAGE_BYTES, EPI_WAVE = 2048;
__host__ __device__ __forceinline__ int lds_byte(int r, int c) { const int st = (r >> 4) * 2 + (c >> 5), rr = r & 15, cc = c & 31, ob = rr * 64 + cc * 2; return st * 1024 + (ob ^ (((ob >> 9) & 1) << 5)); }
__host__ __device__ __forceinline__ void stage_rc(int b, int& R, int& C) { const int st = b / 1024, sb = b % 1024, swz = sb ^ (((sb >> 9) & 1) << 5); R = (st >> 1) * 16 + swz / 64; C = (st & 1) * 32 + (swz % 64) / 2; }
__host__ __device__ __forceinline__ int perm32(int rho) { const int n = rho >> 4, i = rho & 15; return 8 * (i >> 2) + 4 * n + (i & 3); }

struct Unit { int pm, pn; };
struct Gemm { const bf16_t* A; const bf16_t* Bt; int lda, ldb, K; };

struct StaticOrder {
    int nM, nN, nwg, G, c, pm0;
    __host__ __device__ void init(int M, int N, int G_, int c_, int pm0_ = 0) { nM = M / BM; nN = N / BM; nwg = nM * nN; G = G_; c = c_; pm0 = pm0_; }
    __host__ __device__ bool next(int i, Unit& u) const {
        const long L = (long)i * G + c; if (L >= nwg) return false;
        int wgid = (int)L; { const int q = nwg / NXCD, r = nwg % NXCD, xcd = wgid % NXCD, off = wgid / NXCD; wgid = (xcd < r ? xcd * (q + 1) : r * (q + 1) + (xcd - r) * q) + off; }
        const int nig = WGM * nN, gid = wgid / nig, fm = gid * WGM, gsz = (nM - fm) < WGM ? (nM - fm) : WGM;
        u.pm = pm0 + fm + ((wgid % nig) % gsz); u.pn = (wgid % nig) / gsz; return true;
    }
};
__device__ __forceinline__ unsigned cvt_pk_bf16(float lo, float hi) { unsigned r; asm volatile("v_cvt_pk_bf16_f32 %0, %1, %2" : "=v"(r) : "v"(lo), "v"(hi)); return r; }

template <class Epi>
__device__ __forceinline__ void gemm_phase(PG8_LAS unsigned char* lds, const Gemm g, const StaticOrder& S, const Epi& E, int wv) {
    const int tid = TIDX_W(wv), wid = __builtin_amdgcn_readfirstlane(tid >> 6), lane = tid & 63, wr = wid >> 2, wc = wid & 3, fr = lane & 15, fq = lane >> 4;
    const int K = g.K, nt = K / BK;
    unsigned voffA[2], voffB[2];
#pragma unroll
    for (int i = 0; i < 2; ++i) { int R, C; stage_rc(tid * 16 + i * 8192, R, C); const int Rb = Epi::PERM ? ((R >> 5) * 64 + perm32(R & 31)) : R;
        voffA[i] = (unsigned)(R * g.lda + C) * 2u; voffB[i] = (unsigned)(Rb * g.ldb + C) * 2u; }
    const size_t kstep = (size_t)(BK * 2);
    const size_t hstepA = (size_t)HALF * g.lda * 2, hstepB = (size_t)(Epi::PERM ? 32 : HALF) * g.ldb * 2;
    const size_t tstepA = 2 * hstepA, tstepB = (size_t)BM * g.ldb * 2;
    const unsigned ldsw = (unsigned)wid * 1024u;
    const int aoff = lds_byte(wr * 64 + fr, fq * 8), boff = lds_byte(wc * 32 + fr, fq * 8);
#define PG8_SA(b, h) (((b) * 2 + (h)) * HTB)
#define PG8_SB(b, h) ((4 + (b) * 2 + (h)) * HTB)
#define PG8_STAGE(bufoff, gbase, voff) do { _Pragma("unroll") for (int _i = 0; _i < 2; ++_i) \
        __builtin_amdgcn_global_load_lds((const unsigned*)((const char*)(gbase) + (voff)[_i]), (PG8_LAS unsigned*)(lds + (bufoff) + ldsw + _i * 8192), 16, 0, 0); } while (0)
#define PG8_LDA(dst, b, h) do { _Pragma("unroll") for (int m = 0; m < 4; ++m) _Pragma("unroll") for (int k = 0; k < 2; ++k) dst[m][k] = *(const PG8_LAS bf16x8*)(lds + PG8_SA(b, h) + aoff + m * 2048 + k * 1024); } while (0)
#define PG8_LDB(dst, b, h) do { _Pragma("unroll") for (int n = 0; n < 2; ++n) _Pragma("unroll") for (int k = 0; k < 2; ++k) dst[n][k] = *(const PG8_LAS bf16x8*)(lds + PG8_SB(b, h) + boff + n * 2048 + k * 1024); } while (0)
#define PG8_MMA(ai, bj, At, Bt) do { __builtin_amdgcn_s_setprio(1); _Pragma("unroll") for (int m = 0; m < 4; ++m) _Pragma("unroll") for (int n = 0; n < 2; ++n) _Pragma("unroll") for (int k = 0; k < 2; ++k) \
        acc[ai][bj][m][n] = __builtin_amdgcn_mfma_f32_16x16x32_bf16(Bt[n][k], At[m][k], acc[ai][bj][m][n], 0, 0, 0); __builtin_amdgcn_s_setprio(0); } while (0)
#define PG8_WAIT_V(n) asm volatile("s_waitcnt vmcnt(" #n ")" ::: "memory")
#define PG8_WAIT_L(n) asm volatile("s_waitcnt lgkmcnt(" #n ")" ::: "memory")
#define PG8_BAR __builtin_amdgcn_s_barrier()
#define PG8_SCHED __builtin_amdgcn_sched_barrier(0)
    Unit cur, nxt; int ui = 0;
    if (!S.next(0, cur)) return;
    f32x4 acc[2][2][4][2];
#pragma unroll
    for (int a = 0; a < 2; ++a)
#pragma unroll
        for (int b = 0; b < 2; ++b)
#pragma unroll
            for (int m = 0; m < 4; ++m)
#pragma unroll
                for (int n = 0; n < 2; ++n) acc[a][b][m][n] = (f32x4){0.f, 0.f, 0.f, 0.f};
    bf16x8 At[4][2], B0[2][2], B1[2][2];
    const char* cA = (const char*)g.A + (size_t)cur.pm * tstepA; const char* cB = (const char*)g.Bt + (size_t)cur.pn * tstepB;
    PG8_STAGE(PG8_SB(0, 0), cB, voffB); PG8_STAGE(PG8_SB(0, 1), cB + hstepB, voffB); PG8_STAGE(PG8_SA(0, 0), cA, voffA); PG8_STAGE(PG8_SA(0, 1), cA + hstepA, voffA);
    if (wr == 1) PG8_BAR;
    PG8_WAIT_V(2); PG8_BAR;
    PG8_STAGE(PG8_SB(1, 0), cB + kstep, voffB); PG8_STAGE(PG8_SA(1, 0), cA + kstep, voffA); PG8_STAGE(PG8_SB(1, 1), cB + hstepB + kstep, voffB);
    PG8_WAIT_V(6); PG8_BAR;
    for (;;) {
        const bool has_next = S.next(ui + 1, nxt);
        const char* nA = has_next ? (const char*)g.A + (size_t)nxt.pm * tstepA : cA; const char* nB = has_next ? (const char*)g.Bt + (size_t)nxt.pn * tstepB : cB;
        for (int t = 0; t < nt; t += 2) {
            const bool last = (t == nt - 2);
            const char* a1 = cA + (size_t)(t + 1) * kstep;
            const char* a2 = last ? nA : cA + (size_t)(t + 2) * kstep; const char* b2 = last ? nB : cB + (size_t)(t + 2) * kstep;
            const char* a3 = a2 + kstep; const char* b3 = b2 + kstep;
            PG8_LDB(B0, 0, 0); PG8_LDB(B1, 0, 1); PG8_SCHED; PG8_LDA(At, 0, 0); PG8_STAGE(PG8_SA(1, 1), a1 + hstepA, voffA);
            PG8_WAIT_V(8); PG8_WAIT_L(0); PG8_BAR; PG8_MMA(0, 0, At, B0); PG8_MMA(0, 1, At, B1); PG8_BAR; PG8_SCHED;
            PG8_LDA(At, 0, 1); PG8_STAGE(PG8_SB(0, 0), b2, voffB); PG8_STAGE(PG8_SB(0, 1), b2 + hstepB, voffB); PG8_STAGE(PG8_SA(0, 0), a2, voffA);
            PG8_WAIT_V(8); PG8_WAIT_L(0); PG8_BAR; PG8_MMA(1, 0, At, B0); PG8_MMA(1, 1, At, B1); PG8_BAR; PG8_SCHED;
            PG8_LDB(B0, 1, 0); PG8_LDB(B1, 1, 1); PG8_SCHED; PG8_LDA(At, 1, 0); PG8_STAGE(PG8_SA(0, 1), a2 + hstepA, voffA);
            PG8_WAIT_V(8); PG8_WAIT_L(0); PG8_BAR; PG8_MMA(0, 0, At, B0); PG8_MMA(0, 1, At, B1); PG8_BAR; PG8_SCHED;
            PG8_LDA(At, 1, 1); PG8_STAGE(PG8_SB(1, 0), b3, voffB); PG8_STAGE(PG8_SB(1, 1), b3 + hstepB, voffB); PG8_STAGE(PG8_SA(1, 0), a3, voffA);
            PG8_WAIT_V(8); PG8_WAIT_L(0); PG8_BAR; PG8_MMA(1, 0, At, B0); PG8_MMA(1, 1, At, B1); PG8_BAR; PG8_SCHED;
        }
        if (wr == 0) PG8_BAR;
        E(acc, cur, wr, wc, lane_id(), lds + EPI_LDS + wid * EPI_WAVE);
        if (!has_next) break;
#pragma unroll
        for (int a = 0; a < 2; ++a)
#pragma unroll
            for (int b = 0; b < 2; ++b)
#pragma unroll
                for (int m = 0; m < 4; ++m)
#pragma unroll
                    for (int n = 0; n < 2; ++n) acc[a][b][m][n] = (f32x4){0.f, 0.f, 0.f, 0.f};
        cur = nxt; cA = nA; cB = nB; ++ui;
        if (wr == 1) PG8_BAR;
    }
    PG8_WAIT_V(0);
    PG8_BAR;
#undef PG8_SA
#undef PG8_SB
#undef PG8_STAGE
#undef PG8_LDA
#undef PG8_LDB
#undef PG8_MMA
#undef PG8_WAIT_V
#undef PG8_WAIT_L
#undef PG8_BAR
#undef PG8_SCHED
}
typedef f32x4 AccT[2][2][4][2];
__device__ __forceinline__ void xp32_w(PG8_LAS unsigned char* xl, int fr, int c, const f32x4& v) { *(PG8_LAS f32x4*)(xl + fr * 128 + (((c ^ fr) & 7) << 4)) = v; }
__device__ __forceinline__ f32x4 xp32_r(const PG8_LAS unsigned char* xl, int r, int c) { return *(const PG8_LAS f32x4*)(xl + r * 128 + (((c ^ r) & 7) << 4)); }
__device__ __forceinline__ void xpw(PG8_LAS unsigned char* xl, int lane, const u32x4& w0, const u32x4& w1, u32x4& o0, u32x4& o1) {
    const int fr = lane & 15, fq = lane >> 4, t8 = lane >> 3, c8 = lane & 7;
    *(PG8_LAS u32x4*)(xl + fr * 128 + (((fq ^ fr) & 7) << 4)) = w0; *(PG8_LAS u32x4*)(xl + fr * 128 + ((((4 + fq) ^ fr) & 7) << 4)) = w1;
    const PG8_LAS unsigned char* rp = xl + t8 * 128 + (((c8 ^ t8) & 7) << 4);
    o0 = *(const PG8_LAS u32x4*)rp; o1 = *(const PG8_LAS u32x4*)(rp + 1024);
}
__device__ __forceinline__ void xpw_rev(PG8_LAS unsigned char* xl, int lane, const u32x4& w0, const u32x4& w1, u32x4& o0, u32x4& o1) {
    const int fr = lane & 15, fq = lane >> 4, t8 = lane >> 3, c8 = lane & 7;
    PG8_LAS unsigned char* wp = xl + t8 * 128 + (((c8 ^ t8) & 7) << 4);
    *(PG8_LAS u32x4*)wp = w0; *(PG8_LAS u32x4*)(wp + 1024) = w1;
    o0 = *(const PG8_LAS u32x4*)(xl + fr * 128 + (((fq ^ fr) & 7) << 4)); o1 = *(const PG8_LAS u32x4*)(xl + fr * 128 + ((((4 + fq) ^ fr) & 7) << 4));
}
__device__ __forceinline__ u32x4 pack8(const f32x4& v0, const f32x4& v1) { u32x4 w; w.x = cvt_pk_bf16(v0[0], v0[1]); w.y = cvt_pk_bf16(v0[2], v0[3]); w.z = cvt_pk_bf16(v1[0], v1[1]); w.w = cvt_pk_bf16(v1[2], v1[3]); return w; }

struct EpiProj { static constexpr bool PERM = true; bf16_t* proj; float* dt;
    __device__ __forceinline__ void operator()(const AccT& acc, const Unit& u, int wr, int wc, int lane, PG8_LAS unsigned char* xl) const {
        if (u.pn * BM >= PJ) {
            const int fr = lane & 15, fq = lane >> 4, row0 = u.pm * BM + wr * 64 + fr;
            if (wc == 0) {
#pragma unroll
                for (int ai = 0; ai < 2; ++ai)
#pragma unroll
                    for (int m = 0; m < 4; ++m) { float* q = dt + (size_t)(row0 + ai * HALF + m * 16) * NDT + 8 * fq; *(f32x4*)q = acc[ai][0][m][0]; *(f32x4*)(q + 4) = acc[ai][0][m][1];
                        if (fq < 2) { *(f32x4*)(q + 32) = acc[ai][1][m][0]; *(f32x4*)(q + 36) = acc[ai][1][m][1]; } }
            }
            return;
        }
        const int t8 = lane >> 3, c8 = lane & 7;
        bf16_t* q0 = proj + (size_t)(u.pm * BM + wr * 64 + t8) * PJ + u.pn * BM + wc * 64 + 8 * c8;
#pragma unroll
        for (int ai = 0; ai < 2; ++ai)
#pragma unroll
            for (int m = 0; m < 4; ++m) { u32x4 o0, o1;
                xpw(xl, lane, pack8(acc[ai][0][m][0], acc[ai][0][m][1]), pack8(acc[ai][1][m][0], acc[ai][1][m][1]), o0, o1);
                bf16_t* q = q0 + (size_t)(ai * HALF + 16 * m) * PJ;
                { bf16_t* q1 = q + (size_t)8 * PJ;
                  ST16_WT(q, o0); ST16_WT(q1, o1); } }
    } };
struct EpiUt { static constexpr bool PERM = true; bf16_t* ut;
    __device__ __forceinline__ void operator()(const AccT& acc, const Unit& u, int wr, int wc, int lane, PG8_LAS unsigned char* xl) const {
        const int t8 = lane >> 3, c8 = lane & 7;
        const int gc0 = u.pm * BM + wr * 64 + t8, tok = u.pn * BM + wc * 64 + 8 * c8;
        bf16_t* qb; int ld;
        if (tok < MLAT) { const int b = tok / SEQ, l = tok % SEQ; qb = ut + (size_t)b * 512 * SEQ + l; ld = SEQ; }
        else { const int t = tok - MLAT, b = t / CTXL, l = t % CTXL; qb = ut + (size_t)NB * 512 * SEQ + (size_t)b * 512 * CTXL + l; ld = CTXL; }
#pragma unroll
        for (int ai = 0; ai < 2; ++ai)
#pragma unroll
            for (int m = 0; m < 4; ++m) { u32x4 o0, o1;
                xpw(xl, lane, pack8(acc[ai][0][m][0], acc[ai][0][m][1]), pack8(acc[ai][1][m][0], acc[ai][1][m][1]), o0, o1);
                const int gc = gc0 + ai * HALF + 16 * m;
                *(u32x4*)(qb + (size_t)gc * ld) = o0; *(u32x4*)(qb + (size_t)(gc + 8) * ld) = o1; }
    } };
struct EpiPQ { static constexpr bool PERM = true; bf16_t* pq; int rowbase, L; float scale;
    __device__ __forceinline__ void operator()(const AccT& acc, const Unit& u, int wr, int wc, int lane, PG8_LAS unsigned char* xl) const {
        const int t8 = lane >> 3, c8 = lane & 7;
        const int row0 = u.pm * BM + wr * 64 + t8, n = u.pn * BM + wc * 64 + 8 * c8, Lh = L >> 1;
        bf16_t* qn = pq + (size_t)(rowbase + (n >> 9) * L) * 1024 + (n & 511);
#pragma unroll
        for (int ai = 0; ai < 2; ++ai)
#pragma unroll
            for (int m = 0; m < 4; ++m) { u32x4 o[2];
                xpw(xl, lane, pack8(acc[ai][0][m][0] * scale, acc[ai][0][m][1] * scale), pack8(acc[ai][1][m][0] * scale, acc[ai][1][m][1] * scale), o[0], o[1]);
#pragma unroll
                for (int s_ = 0; s_ < 2; ++s_) { const int r = row0 + ai * HALF + 16 * m + 8 * s_, part = r >= Lh ? 1 : 0, k = r - part * Lh + 1;
                    bf16_t* q = qn + part * 512;
                    *(u32x4*)(q + (size_t)k * 1024) = o[s_];
                    if (k < Lh) { const unsigned sm = part ? 0x80008000u : 0u; u32x4 w = o[s_]; w.x ^= sm; w.y ^= sm; w.z ^= sm; w.w ^= sm;
                        *(u32x4*)(q + (size_t)(L - k) * 1024) = w; } } }
    } };
struct EpiFl { static constexpr bool PERM = true; bf16_t* proj; const float* bias;
    __device__ __forceinline__ void operator()(const AccT& acc, const Unit& u, int wr, int wc, int lane, PG8_LAS unsigned char* xl) const {
        const int fq = lane >> 4, t8 = lane >> 3, c8 = lane & 7;
        f32x4 bv[2][2];
#pragma unroll
        for (int bj = 0; bj < 2; ++bj)
#pragma unroll
            for (int n = 0; n < 2; ++n) bv[bj][n] = *(const f32x4*)(bias + u.pn * BM + wc * 64 + bj * 32 + 8 * fq + 4 * n);
        bf16_t* q0 = proj + (size_t)(u.pm * BM + wr * 64 + t8) * PJ + PJ_ZF + u.pn * BM + wc * 64 + 8 * c8;
#pragma unroll
        for (int ai = 0; ai < 2; ++ai) {
            u32x4 z[4][2];
#pragma unroll
            for (int m = 0; m < 4; ++m)
#pragma unroll
                for (int s_ = 0; s_ < 2; ++s_) z[m][s_] = *(const u32x4*)(q0 + (size_t)(ai * HALF + m * 16 + 8 * s_) * PJ);
#pragma unroll
            for (int m = 0; m < 4; ++m) { u32x4 zf[2], w[2], o0, o1;
                xpw_rev(xl, lane, z[m][0], z[m][1], zf[0], zf[1]);
#pragma unroll
                for (int bj = 0; bj < 2; ++bj) { const f32x4 v0 = acc[ai][bj][m][0] + bv[bj][0], v1 = acc[ai][bj][m][1] + bv[bj][1]; const u32x4 zz = zf[bj];
                    w[bj].x = cvt_pk_bf16(v0[0] * silu_f(bf2f(zz.x & 0xffffu)), v0[1] * silu_f(bf2f_hi(zz.x))); w[bj].y = cvt_pk_bf16(v0[2] * silu_f(bf2f(zz.y & 0xffffu)), v0[3] * silu_f(bf2f_hi(zz.y)));
                    w[bj].z = cvt_pk_bf16(v1[0] * silu_f(bf2f(zz.z & 0xffffu)), v1[1] * silu_f(bf2f_hi(zz.z))); w[bj].w = cvt_pk_bf16(v1[2] * silu_f(bf2f(zz.w & 0xffffu)), v1[3] * silu_f(bf2f_hi(zz.w))); }
                xpw(xl, lane, w[0], w[1], o0, o1);
                bf16_t* q = q0 + (size_t)(ai * HALF + m * 16) * PJ;
                *(u32x4*)q = o0; *(u32x4*)(q + (size_t)8 * PJ) = o1; }
            asm volatile("" ::: "memory"); }
    } };
struct EpiOut { static constexpr bool PERM = false; const float* xsrc; float* xdst; const float* csrc; float* cdst; const float* mod;
    __device__ __forceinline__ void operator()(const AccT& acc, const Unit& u, int wr, int wc, int lane, PG8_LAS unsigned char* xl) const {
        const int fr = lane & 15, fq = lane >> 4, t8 = lane >> 3, c8 = lane & 7;
        const int row0 = u.pm * BM + wr * 64 + t8, col0 = u.pn * BM + wc * 32 + 4 * c8;
        const bool lat = u.pm < MLAT / BM;
        const float* gp = mod + (lat ? (u.pm >> 3) : 8) * 3072 + 2048 + col0;
        const float* src = lat ? xsrc : csrc - (size_t)MLAT * DM; float* dst = lat ? xdst : cdst - (size_t)MLAT * DM;
        f32x4 gv[2];
#pragma unroll
        for (int bj = 0; bj < 2; ++bj) gv[bj] = *(const f32x4*)(gp + bj * HALF);
#pragma unroll
        for (int ai = 0; ai < 2; ++ai)
#pragma unroll
            for (int mp = 0; mp < 2; ++mp) {
                f32x4 bs[2][2][2];
#pragma unroll
                for (int mm = 0; mm < 2; ++mm)
#pragma unroll
                    for (int bj = 0; bj < 2; ++bj)
#pragma unroll
                        for (int s_ = 0; s_ < 2; ++s_) bs[mm][bj][s_] = *(const f32x4*)(src + (size_t)(row0 + ai * HALF + (2 * mp + mm) * 16 + 8 * s_) * DM + col0 + bj * HALF);
#pragma unroll
                for (int mm = 0; mm < 2; ++mm)
#pragma unroll
                    for (int bj = 0; bj < 2; ++bj) { const int m = 2 * mp + mm;
                        xp32_w(xl, fr, fq, acc[ai][bj][m][0]); xp32_w(xl, fr, 4 + fq, acc[ai][bj][m][1]);
#pragma unroll
                        for (int s_ = 0; s_ < 2; ++s_) { const size_t off = (size_t)(row0 + ai * HALF + m * 16 + 8 * s_) * DM + col0 + bj * HALF;
                            *(f32x4*)(dst + off) = bs[mm][bj][s_] + gv[bj] * xp32_r(xl, 8 * s_ + t8, c8); } }
                asm volatile("" ::: "memory"); }
    } };
struct EpiOutNorm { static constexpr bool PERM = false; const float* xsrc; float* xdst; const float* csrc; float* cdst; const float* mod; const float* nw; const float* nmod; bf16_t* Hn; float* rsq; unsigned* cnt; unsigned target;
    __device__ __forceinline__ void operator()(const AccT& acc, const Unit& u, int wr, int wc, int lane_, PG8_LAS unsigned char* xl) const {
        const int lane = opaque_i(lane_);
        const int fr = lane & 15, fq = lane >> 4, t8 = lane >> 3, c8 = lane & 7, wid = wr * 4 + wc, tid = wid * 64 + lane;
        const int row0 = u.pm * BM + wr * 64 + t8, col0 = u.pn * BM + wc * 32 + 4 * c8;
        PG8_LAS unsigned char* sh = xl - wid * EPI_WAVE;
        const bool lat = u.pm < MLAT / BM; const int mrow = lat ? (u.pm >> 3) : 8;
        const float* gp = mod + mrow * 3072 + 2048 + col0;
        const float* src = lat ? xsrc : csrc - (size_t)MLAT * DM; float* dst = lat ? xdst : cdst - (size_t)MLAT * DM;
        f32x4 gv[2];
#pragma unroll
        for (int bj = 0; bj < 2; ++bj) gv[bj] = *(const f32x4*)(gp + bj * HALF);
        f32x4 xn[2][4][2][2];
        float ssq[2][4][2];
#pragma unroll
        for (int ai = 0; ai < 2; ++ai)
#pragma unroll
            for (int mp = 0; mp < 2; ++mp) {
                f32x4 bs[2][2][2];
#pragma unroll
                for (int mm = 0; mm < 2; ++mm)
#pragma unroll
                    for (int bj = 0; bj < 2; ++bj)
#pragma unroll
                        for (int s_ = 0; s_ < 2; ++s_) bs[mm][bj][s_] = *(const f32x4*)(src + (size_t)(row0 + ai * HALF + (2 * mp + mm) * 16 + 8 * s_) * DM + col0 + bj * HALF);
#pragma unroll
                for (int mm = 0; mm < 2; ++mm) { const int m = 2 * mp + mm;
#pragma unroll
                    for (int bj = 0; bj < 2; ++bj) {
                        xp32_w(xl, fr, fq, acc[ai][bj][m][0]); xp32_w(xl, fr, 4 + fq, acc[ai][bj][m][1]);
#pragma unroll
                        for (int s_ = 0; s_ < 2; ++s_) xn[ai][m][bj][s_] = bs[mm][bj][s_] + gv[bj] * xp32_r(xl, 8 * s_ + t8, c8); }
#pragma unroll
                    for (int s_ = 0; s_ < 2; ++s_) { const f32x4 a = xn[ai][m][0][s_], b = xn[ai][m][1][s_];
                        ssq[ai][m][s_] = a.x * a.x + a.y * a.y + a.z * a.z + a.w * a.w + b.x * b.x + b.y * b.y + b.z * b.z + b.w * b.w; } }
                asm volatile("" ::: "memory"); }
#pragma unroll
        for (int o = 1; o < 8; o <<= 1)
#pragma unroll
            for (int ai = 0; ai < 2; ++ai)
#pragma unroll
                for (int m = 0; m < 4; ++m)
#pragma unroll
                    for (int s_ = 0; s_ < 2; ++s_) ssq[ai][m][s_] += __int_as_float(__builtin_amdgcn_ds_bpermute((lane ^ o) << 2, __float_as_int(ssq[ai][m][s_])));
        asm volatile("s_waitcnt lgkmcnt(0)" ::: "memory"); __builtin_amdgcn_s_barrier();
        if (c8 == 0) {
#pragma unroll
            for (int ai = 0; ai < 2; ++ai)
#pragma unroll
                for (int m = 0; m < 4; ++m)
#pragma unroll
                    for (int s_ = 0; s_ < 2; ++s_) *(PG8_LAS float*)(sh + (wc * 256 + wr * 64 + ai * HALF + m * 16 + 8 * s_ + t8) * 4) = ssq[ai][m][s_]; }
        asm volatile("s_waitcnt lgkmcnt(0)" ::: "memory"); __builtin_amdgcn_s_barrier();
        if (tid < 256) { const float t = *(PG8_LAS float*)(sh + tid * 4) + *(PG8_LAS float*)(sh + (256 + tid) * 4) + *(PG8_LAS float*)(sh + (512 + tid) * 4) + *(PG8_LAS float*)(sh + (768 + tid) * 4);
            __hip_atomic_store(rsq + (size_t)(u.pm * BM + tid) * 4 + u.pn, t, __ATOMIC_RELAXED, __HIP_MEMORY_SCOPE_AGENT); }
        asm volatile("s_waitcnt vmcnt(0)" ::: "memory"); __builtin_amdgcn_s_barrier();
        if (tid == 0) {
            (void)__hip_atomic_fetch_add(cnt + 64 * u.pm, 1u, __ATOMIC_RELAXED, __HIP_MEMORY_SCOPE_AGENT);
            unsigned sp = 0; while (__hip_atomic_load(cnt + 64 * u.pm, __ATOMIC_RELAXED, __HIP_MEMORY_SCOPE_AGENT) < target) { __builtin_amdgcn_s_sleep(2); if (++sp > (1u << 21)) break; } }
        __builtin_amdgcn_s_barrier(); asm volatile("" ::: "memory");
        if (tid < 256) { const float* rp = rsq + (size_t)(u.pm * BM + tid) * 4;
            const float q0 = __hip_atomic_load(rp, __ATOMIC_RELAXED, __HIP_MEMORY_SCOPE_AGENT), q1 = __hip_atomic_load(rp + 1, __ATOMIC_RELAXED, __HIP_MEMORY_SCOPE_AGENT),
                        q2 = __hip_atomic_load(rp + 2, __ATOMIC_RELAXED, __HIP_MEMORY_SCOPE_AGENT), q3 = __hip_atomic_load(rp + 3, __ATOMIC_RELAXED, __HIP_MEMORY_SCOPE_AGENT);
            *(PG8_LAS float*)(sh + 4096 + tid * 4) = rsqrtf(((q0 + q1) + (q2 + q3)) * (1.f / DM) + EPS); }
        asm volatile("s_waitcnt lgkmcnt(0)" ::: "memory"); __builtin_amdgcn_s_barrier();
#pragma unroll
        for (int ai = 0; ai < 2; ++ai)
#pragma unroll
            for (int m = 0; m < 4; ++m)
#pragma unroll
                for (int s_ = 0; s_ < 2; ++s_)
#pragma unroll
                    for (int bj = 0; bj < 2; ++bj) *(f32x4*)(dst + (size_t)(row0 + ai * HALF + m * 16 + 8 * s_) * DM + col0 + bj * HALF) = xn[ai][m][bj][s_];
        const float* sh_ = nmod + mrow * 3072 + col0;
        f32x4 gw[2], s0[2];
#pragma unroll
        for (int bj = 0; bj < 2; ++bj) { const f32x4 w = *(const f32x4*)(nw + col0 + bj * HALF), s1 = *(const f32x4*)(sh_ + 1024 + bj * HALF);
            gw[bj] = (f32x4){w.x * (1.f + s1.x), w.y * (1.f + s1.y), w.z * (1.f + s1.z), w.w * (1.f + s1.w)}; s0[bj] = *(const f32x4*)(sh_ + bj * HALF); }
#pragma unroll
        for (int ai = 0; ai < 2; ++ai)
#pragma unroll
            for (int m = 0; m < 4; ++m)
#pragma unroll
                for (int s_ = 0; s_ < 2; ++s_) { const int rl = wr * 64 + ai * HALF + m * 16 + 8 * s_ + t8; const float ri = *(PG8_LAS float*)(sh + 4096 + rl * 4);
#pragma unroll
                    for (int bj = 0; bj < 2; ++bj) { const f32x4 v = xn[ai][m][bj][s_];
                        u32x2 o; o.x = cvt_pk_bf16(v.x * ri * gw[bj].x + s0[bj].x, v.y * ri * gw[bj].y + s0[bj].y); o.y = cvt_pk_bf16(v.z * ri * gw[bj].z + s0[bj].z, v.w * ri * gw[bj].w + s0[bj].w);
                        *(u32x2*)(Hn + (size_t)(u.pm * BM + rl) * DM + col0 + bj * HALF) = o; } }
    } };
struct EpiOutFin { static constexpr bool PERM = false; const float* xsrc; float* out; const float* mod; const float* fw; float* rsq; unsigned* cnt; unsigned target;
    __device__ __forceinline__ void operator()(const AccT& acc, const Unit& u, int wr, int wc, int lane_, PG8_LAS unsigned char* xl) const {
        const int lane = opaque_i(lane_);
        const int fr = lane & 15, fq = lane >> 4, t8 = lane >> 3, c8 = lane & 7, wid = wr * 4 + wc, tid = wid * 64 + lane;
        const int row0 = u.pm * BM + wr * 64 + t8, col0 = u.pn * BM + wc * 32 + 4 * c8;
        PG8_LAS unsigned char* sh = xl - wid * EPI_WAVE;
        const float* gp = mod + (u.pm >> 3) * 3072 + 2048 + col0;
        f32x4 gv[2];
#pragma unroll
        for (int bj = 0; bj < 2; ++bj) gv[bj] = *(const f32x4*)(gp + bj * HALF);
        f32x4 xn[2][4][2][2];
        float ssq[2][4][2];
#pragma unroll
        for (int ai = 0; ai < 2; ++ai)
#pragma unroll
            for (int mp = 0; mp < 2; ++mp) {
                f32x4 bs[2][2][2];
#pragma unroll
                for (int mm = 0; mm < 2; ++mm)
#pragma unroll
                    for (int bj = 0; bj < 2; ++bj)
#pragma unroll
                        for (int s_ = 0; s_ < 2; ++s_) bs[mm][bj][s_] = *(const f32x4*)(xsrc + (size_t)(row0 + ai * HALF + (2 * mp + mm) * 16 + 8 * s_) * DM + col0 + bj * HALF);
#pragma unroll
                for (int mm = 0; mm < 2; ++mm) { const int m = 2 * mp + mm;
#pragma unroll
                    for (int bj = 0; bj < 2; ++bj) {
                        xp32_w(xl, fr, fq, acc[ai][bj][m][0]); xp32_w(xl, fr, 4 + fq, acc[ai][bj][m][1]);
#pragma unroll
                        for (int s_ = 0; s_ < 2; ++s_) xn[ai][m][bj][s_] = bs[mm][bj][s_] + gv[bj] * xp32_r(xl, 8 * s_ + t8, c8); }
#pragma unroll
                    for (int s_ = 0; s_ < 2; ++s_) { const f32x4 a = xn[ai][m][0][s_], b = xn[ai][m][1][s_];
                        ssq[ai][m][s_] = a.x * a.x + a.y * a.y + a.z * a.z + a.w * a.w + b.x * b.x + b.y * b.y + b.z * b.z + b.w * b.w; } }
                asm volatile("" ::: "memory"); }
#pragma unroll
        for (int o = 1; o < 8; o <<= 1)
#pragma unroll
            for (int ai = 0; ai < 2; ++ai)
#pragma unroll
                for (int m = 0; m < 4; ++m)
#pragma unroll
                    for (int s_ = 0; s_ < 2; ++s_) ssq[ai][m][s_] += __int_as_float(__builtin_amdgcn_ds_bpermute((lane ^ o) << 2, __float_as_int(ssq[ai][m][s_])));
        asm volatile("s_waitcnt lgkmcnt(0)" ::: "memory"); __builtin_amdgcn_s_barrier();
        if (c8 == 0) {
#pragma unroll
            for (int ai = 0; ai < 2; ++ai)
#pragma unroll
                for (int m = 0; m < 4; ++m)
#pragma unroll
                    for (int s_ = 0; s_ < 2; ++s_) *(PG8_LAS float*)(sh + (wc * 256 + wr * 64 + ai * HALF + m * 16 + 8 * s_ + t8) * 4) = ssq[ai][m][s_]; }
        asm volatile("s_waitcnt lgkmcnt(0)" ::: "memory"); __builtin_amdgcn_s_barrier();
        if (tid < 256) { const float t = *(PG8_LAS float*)(sh + tid * 4) + *(PG8_LAS float*)(sh + (256 + tid) * 4) + *(PG8_LAS float*)(sh + (512 + tid) * 4) + *(PG8_LAS float*)(sh + (768 + tid) * 4);
            __hip_atomic_store(rsq + (size_t)(u.pm * BM + tid) * 4 + u.pn, t, __ATOMIC_RELAXED, __HIP_MEMORY_SCOPE_AGENT); }
        asm volatile("s_waitcnt vmcnt(0)" ::: "memory"); __builtin_amdgcn_s_barrier();
        if (tid == 0) {
            (void)__hip_atomic_fetch_add(cnt + 64 * u.pm, 1u, __ATOMIC_RELAXED, __HIP_MEMORY_SCOPE_AGENT);
            unsigned sp = 0; while (__hip_atomic_load(cnt + 64 * u.pm, __ATOMIC_RELAXED, __HIP_MEMORY_SCOPE_AGENT) < target) { __builtin_amdgcn_s_sleep(2); if (++sp > (1u << 21)) break; } }
        __builtin_amdgcn_s_barrier(); asm volatile("" ::: "memory");
        if (tid < 256) { const float* rp = rsq + (size_t)(u.pm * BM + tid) * 4;
            const float q0 = __hip_atomic_load(rp, __ATOMIC_RELAXED, __HIP_MEMORY_SCOPE_AGENT), q1 = __hip_atomic_load(rp + 1, __ATOMIC_RELAXED, __HIP_MEMORY_SCOPE_AGENT),
                        q2 = __hip_atomic_load(rp + 2, __ATOMIC_RELAXED, __HIP_MEMORY_SCOPE_AGENT), q3 = __hip_atomic_load(rp + 3, __ATOMIC_RELAXED, __HIP_MEMORY_SCOPE_AGENT);
            *(PG8_LAS float*)(sh + 4096 + tid * 4) = rsqrtf(((q0 + q1) + (q2 + q3)) * (1.f / DM) + EPS); }
        asm volatile("s_waitcnt lgkmcnt(0)" ::: "memory"); __builtin_amdgcn_s_barrier();
        f32x4 wv[2];
#pragma unroll
        for (int bj = 0; bj < 2; ++bj) wv[bj] = *(const f32x4*)(fw + col0 + bj * HALF);
#pragma unroll
        for (int ai = 0; ai < 2; ++ai)
#pragma unroll
            for (int m = 0; m < 4; ++m)
#pragma unroll
                for (int s_ = 0; s_ < 2; ++s_) { const int rl = wr * 64 + ai * HALF + m * 16 + 8 * s_ + t8; const float ri = *(PG8_LAS float*)(sh + 4096 + rl * 4);
#pragma unroll
                    for (int bj = 0; bj < 2; ++bj) { const f32x4 v = xn[ai][m][bj][s_];
                        *(f32x4*)(out + (size_t)(u.pm * BM + rl) * DM + col0 + bj * HALF) = (f32x4){v.x * ri * wv[bj].x, v.y * ri * wv[bj].y, v.z * ri * wv[bj].z, v.w * ri * wv[bj].w}; } }
    } };
}
template <class Epi>
__device__ __forceinline__ int fgemm_all_(int wv, unsigned char* smem, const bf16_t* A, int lda, const bf16_t* Bt, int ldb, int M, int N, int K, const Epi& epi, int first, int bid, int G, int row0 = 0) {
    if (bid < 0) return (M / 256) * (N / 256);
    pg8::StaticOrder S; S.init(M, N, G, (bid - first % G + G) % G, row0 / 256);
    pg8::gemm_phase<Epi>((PG8_LAS unsigned char*)smem, pg8::Gemm{A, Bt, lda, ldb, K}, S, epi, wv);
    return S.nwg;
}

__device__ __forceinline__ void ph_conv(const Params& p, unsigned char* smem, int layer, int it0, int it1, int bid, int G) {
    bf16_t* proj = (bf16_t*)(p.ws + WS_PROJ);
    const float* cw = p.conv_w + (size_t)layer * 9 * CONVCH; const float* cb = p.conv_b + (size_t)layer * CONVCH;
    const int tid = TIDX;
    constexpr int NCB = CONVCH / 32;
    if (bid < 0) return;
    const int cq = tid & 7, tl = tid >> 3;
    u32x4 pre[16];
#define CONV_CBLK(r_) ({ const int r__ = (r_), c__ = 8 * (r__ >> 4) + (r__ & 7); 2 * c__ + ((r__ >> 3) & 1); })
#define CONV_ISSUE(it_) do { const bf16_t* b_ = proj + (size_t)((it_) / NCB * SEQ) * PJ + PJ_XS + CONV_CBLK((it_) % NCB) * 32; \
        _Pragma("unroll") for (int q = 0; q < 16; ++q) { const int e = tid + NT * q; pre[q] = *(const u32x4*)(b_ + (size_t)(e >> 2) * PJ + (e & 3) * 8); } } while (0)
    const int lat_end = it1 < 8 * NCB ? it1 : 8 * NCB;
    constexpr int CW = GRIDW + 2, CH_ = SEQ / GRIDW + 2;
    if (it0 + bid < lat_end) {
        for (int s = tid; s < CH_ * CW; s += NT) { const int rr = s / CW, cc = s % CW;
            if (rr == 0 || rr == CH_ - 1 || cc == 0 || cc == CW - 1) { const unsigned z_ = (unsigned)opaque_i(0); const u32x4 zv = (u32x4){z_, z_, z_, z_};
                *(u32x4*)(smem + s * 64) = zv; *(u32x4*)(smem + s * 64 + 16) = zv; *(u32x4*)(smem + s * 64 + 32) = zv; *(u32x4*)(smem + s * 64 + 48) = zv; } }
    }
    int it = it0 + bid;
    if (it < lat_end) CONV_ISSUE(it);
    for (; it < it1; it += G) {
        const int sq = it / NCB, cblk = CONV_CBLK(it % NCB);
        int L, rows, cols, row0;
        if (sq < 8) { L = SEQ; rows = SEQ / GRIDW; cols = GRIDW; row0 = sq * SEQ; } else { L = CTXL; rows = 1; cols = CTXL; row0 = MLAT + (sq - 8) * CTXL; }
        bf16_t* base = proj + (size_t)row0 * PJ + PJ_XS + cblk * 32;
        if (sq < 8) {
#pragma unroll
            for (int q = 0; q < 16; ++q) { const int e = tid + NT * q, t = e >> 2; *(u32x4*)(smem + (((t >> 6) + 1) * CW + 1 + (t & 63)) * 64 + (e & 3) * 16) = pre[q]; }
        } else {
            for (int e = tid; e < L * 4; e += NT) { const int t = e >> 2, q = e & 3; *(u32x4*)(smem + t * 64 + q * 16) = *(const u32x4*)(base + (size_t)t * PJ + q * 8); }
        }
        __syncthreads();
        if (it + G < lat_end) CONV_ISSUE(it + G);
        const int ch = cblk * 32 + cq * 4;
        float w[9][4], bias[4];
#pragma unroll
        for (int k = 0; k < 9; ++k)
#pragma unroll
            for (int j = 0; j < 4; ++j) w[k][j] = cw[k * CONVCH + ch + j];
#pragma unroll
        for (int j = 0; j < 4; ++j) bias[j] = cb[ch + j];
        if (sq < 8) {
            const int c = tl;
            const unsigned char* colp = smem + (size_t)c * 64 + cq * 8;
            float W0[3][4], W1[3][4], W2[3][4];
#define CONV_LD(dst_, R_) do { const unsigned char* rp_ = colp + (size_t)(R_) * (CW * 64); const u32x2 v0_ = *(const u32x2*)rp_, v1_ = *(const u32x2*)(rp_ + 64), v2_ = *(const u32x2*)(rp_ + 128); \
                dst_[0][0] = bf2f(v0_.x & 0xffffu); dst_[0][1] = bf2f_hi(v0_.x); dst_[0][2] = bf2f(v0_.y & 0xffffu); dst_[0][3] = bf2f_hi(v0_.y); \
                dst_[1][0] = bf2f(v1_.x & 0xffffu); dst_[1][1] = bf2f_hi(v1_.x); dst_[1][2] = bf2f(v1_.y & 0xffffu); dst_[1][3] = bf2f_hi(v1_.y); \
                dst_[2][0] = bf2f(v2_.x & 0xffffu); dst_[2][1] = bf2f_hi(v2_.x); dst_[2][2] = bf2f(v2_.y & 0xffffu); dst_[2][3] = bf2f_hi(v2_.y); } while (0)
#define CONV_STEP(r_, T_, M_, B_) do { CONV_LD(B_, (r_) + 2); float a_[4] = {bias[0], bias[1], bias[2], bias[3]}; \
                _Pragma("unroll") for (int j = 0; j < 3; ++j) _Pragma("unroll") for (int e = 0; e < 4; ++e) a_[e] += w[j][e] * T_[j][e] + w[3 + j][e] * M_[j][e] + w[6 + j][e] * B_[j][e]; \
                u32x2 o_; o_.x = pk2(silu_f(a_[0]), silu_f(a_[1])); o_.y = pk2(silu_f(a_[2]), silu_f(a_[3])); \
                *(u32x2*)(base + (size_t)((r_) * GRIDW + c) * PJ + cq * 4) = o_; } while (0)
            CONV_LD(W0, 0); CONV_LD(W1, 1);
            for (int r = 0; r < SEQ / GRIDW; r += 3) {
                CONV_STEP(r, W0, W1, W2);
                if (r + 1 < SEQ / GRIDW) CONV_STEP(r + 1, W1, W2, W0);
                if (r + 2 < SEQ / GRIDW) CONV_STEP(r + 2, W2, W0, W1);
            }
#undef CONV_LD
#undef CONV_STEP
        } else {
            for (int t = tl; t < CTXL; t += 64) {
                float a[4] = {bias[0], bias[1], bias[2], bias[3]};
#pragma unroll
                for (int j = 0; j < 3; ++j) { const int c2 = t + j - 1; if (c2 < 0 || c2 >= CTXL) continue;
                    const u32x2 v = *(const u32x2*)(smem + c2 * 64 + cq * 8);
                    a[0] += w[3 + j][0] * bf2f(v.x & 0xffffu); a[1] += w[3 + j][1] * bf2f_hi(v.x); a[2] += w[3 + j][2] * bf2f(v.y & 0xffffu); a[3] += w[3 + j][3] * bf2f_hi(v.y); }
                u32x2 o; o.x = pk2(silu_f(a[0]), silu_f(a[1])); o.y = pk2(silu_f(a[2]), silu_f(a[3]));
                *(u32x2*)(base + (size_t)t * PJ + cq * 4) = o;
            }
        }
        __syncthreads();
    }
#undef CONV_ISSUE
#undef CONV_CBLK
}

constexpr int CW_IDLE = 8192, CW_CTXDONE = 8256;
__device__ __forceinline__ void cnt_signal(unsigned* cnt, int wv) {
    asm volatile("s_waitcnt vmcnt(0)" ::: "memory");
    __syncthreads();
    if (wv == 0 && lane_id() == 0) { __builtin_amdgcn_fence(__ATOMIC_RELEASE, "agent"); asm volatile("s_waitcnt vmcnt(0)" ::: "memory"); (void)__hip_atomic_fetch_add(cnt, 1u, __ATOMIC_RELAXED, __HIP_MEMORY_SCOPE_AGENT); }
}
__device__ __forceinline__ void cnt_signal_wt(unsigned* cnt, int wv) {
    asm volatile("s_waitcnt vmcnt(0)" ::: "memory");
    __syncthreads();
    if (wv == 0 && lane_id() == 0) (void)__hip_atomic_fetch_add(cnt, 1u, __ATOMIC_RELAXED, __HIP_MEMORY_SCOPE_AGENT);
}
__device__ __forceinline__ void cnt_wait(unsigned* cnt, unsigned target, int wv) {
    if (wv == 0 && lane_id() == 0) {
        unsigned sp = 0; while (__hip_atomic_load(cnt, __ATOMIC_RELAXED, __HIP_MEMORY_SCOPE_AGENT) < target) { __builtin_amdgcn_s_sleep(2); if (++sp > (1u << 21)) break; }
    }
    __syncthreads();
    __builtin_amdgcn_fence(__ATOMIC_ACQUIRE, "agent"); asm volatile("s_waitcnt vmcnt(0)" ::: "memory");
}

namespace ssd {
#define LAS __attribute__((address_space(3)))
typedef float f32x16 __attribute__((ext_vector_type(16)));
typedef float f32x8 __attribute__((ext_vector_type(8)));
typedef short s16x4 __attribute__((ext_vector_type(4)));
typedef __bf16 bf16v8 __attribute__((ext_vector_type(8)));
constexpr int OFF_BH = 0, OFF_XH = 16384, OFF_SIMG = 32768, OFF_TAB = 49152, TABSZ = 3072, OFF_YST = 49152 + 2 * TABSZ, TEAM_BYTES = OFF_YST + 16384;
constexpr int T_ACUM = 0, T_DT = 512, T_RF = 1024, T_W = 1536, T_EAC = 2048, T_E = 2560;
constexpr int NCHUNK = (CTXL + SEQ) / 128;
__device__ __forceinline__ unsigned off_b(unsigned row, unsigned ch) { return 256u * row + 16u * (ch ^ (((row & 3) << 2) | ((row >> 2) & 3))); }
__device__ __forceinline__ int crow(int r, int h) { return (r & 3) + 8 * (r >> 2) + 4 * h; }
#define MFMA32(a, b, c) __builtin_amdgcn_mfma_f32_32x32x16_bf16((a), (b), (c), 0, 0, 0)
__device__ __forceinline__ LAS unsigned char* las_ptr(unsigned a) { return (LAS unsigned char*)(size_t)a; }
__device__ __forceinline__ unsigned las_int(LAS unsigned char* p) { return (unsigned)(size_t)p; }
__device__ __forceinline__ bf16x8 trpair(LAS unsigned char* p0, LAS unsigned char* p1) {
    const s16x4 lo = __builtin_amdgcn_ds_read_tr16_b64_v4i16((LAS s16x4*)p0), hi = __builtin_amdgcn_ds_read_tr16_b64_v4i16((LAS s16x4*)p1);
    return __builtin_shufflevector(lo, hi, 0, 1, 2, 3, 4, 5, 6, 7);
}

__device__ __forceinline__ void ph_ssd(const Params& p, unsigned char* smem_, int layer, int bid, int G) {
    const int tid = TIDX, lane0 = tid & 63, wave = __builtin_amdgcn_readfirstlane(tid >> 6), d = wave >> 2, wi = wave & 3;
    const int i = d ? 3 - wi : wi, nb = wi;
    int lane = lane0, tt = tid & 255, h = lane >> 5, l31 = lane & 31;
    LAS unsigned char* lb = (LAS unsigned char*)smem_ + d * TEAM_BYTES;
    LAS unsigned char* BH = lb + OFF_BH; LAS unsigned char* XH = lb + OFF_XH; LAS unsigned char* SIMG = lb + OFF_SIMG;
    LAS unsigned char* YST = lb + OFF_YST;
    const bool tabwave = (i == 0);
    bf16_t* proj = (bf16_t*)(p.ws + WS_PROJ); const float* dtb = (const float*)(p.ws + WS_DT); bf16_t* stash = (bf16_t*)(p.ws + WS_STASH);
    unsigned tq = (lane & 15) >> 2, tp = lane & 3, tblk = (lane >> 4) & 1;
    for (int it = bid; it < NB * NH; it += G) {
        const int b = it % NB, head = it / NB, g = head / HPG;
        const float Aneg = -__expf(p.a_log[(layer * 2 + d) * NH + head]), dbias = p.dt_bias[(layer * 2 + d) * NH + head];
        const float dskip = d ? 0.f : p.d_skip[layer * NH + head];
        f32x16 st[2];
#pragma unroll
        for (int r = 0; r < 16; ++r) { st[0][r] = 0.f; st[1][r] = 0.f; }
#pragma unroll
        for (int q = 0; q < 4; ++q) { const unsigned z_ = (unsigned)opaque_i(0); *(LAS u32x4*)(SIMG + (tt + 256 * q) * 16) = (u32x4){z_, z_, z_, z_}; }
#define SSD_BASE(k_) ({ const int c_ = d ? ((k_) < 2 ? 1 - (k_) : NCHUNK + 1 - (k_)) : (k_); c_ < 2 ? MLAT + b * CTXL + 128 * c_ : b * SEQ + 128 * (c_ - 2); })
#define SSD_ROW(base_, t_) ((base_) + (d ? 127 - (t_) : (t_)))
#define SSD_TL(t_) ((unsigned)(d ? 127 - (t_) : (t_)))
#define SSD_PB(base_) ((const char*)proj + (size_t)(base_) * (PJ * 2))
#define SSD_SB(base_) ((char*)stash + (size_t)(base_) * (DSSD * 2))
#define SSD_LD_B(base_, half_, br_) do { _Pragma("unroll") for (int q = 0; q < 4; ++q) { const int t_ = 64 * (half_) + (tt >> 4) + 16 * q; \
            br_[q] = *(const u32x4*)(SSD_PB(base_) + (__umul24(SSD_TL(t_), (unsigned)(PJ * 2)) + (unsigned)((PJ_B + g * DSTATE + (tt & 15) * 8) * 2))); } } while (0)
#define SSD_ST_B(br_) do { _Pragma("unroll") for (int q = 0; q < 4; ++q) { const int tl_ = (tt >> 4) + 16 * q; \
            *(LAS u32x4*)(BH + (tl_ >> 5) * 8192 + off_b(tl_ & 31, tt & 15)) = br_[q]; } } while (0)
#define SSD_LD_X(base_, half_, xr_) do { _Pragma("unroll") for (int q = 0; q < 2; ++q) { const int t_ = 64 * (half_) + (tt >> 3) + 32 * q; \
            xr_[q] = *(const u32x4*)(SSD_PB(base_) + (__umul24(SSD_TL(t_), (unsigned)(PJ * 2)) + (unsigned)((PJ_XS + head * HD + (tt & 7) * 8) * 2))); } } while (0)
#define SSD_ST_X(xr_) do { _Pragma("unroll") for (int q = 0; q < 2; ++q) *(LAS u32x4*)(XH + q * 8192 + off_b(tt >> 3, tt & 7)) = xr_[q]; } while (0)
#define SSD_ST_XW(half_, xr_) do { _Pragma("unroll") for (int q = 0; q < 2; ++q) { const float w_ = *(LAS float*)(TAB + T_W + (64 * (half_) + 32 * q + (tt >> 3)) * 4); const u32x4 v_ = xr_[q]; u32x4 o_; \
            o_.x = pk2(fmul1(bf2f(v_.x & 0xffffu), w_), fmul1(bf2f_hi(v_.x), w_)); o_.y = pk2(fmul1(bf2f(v_.y & 0xffffu), w_), fmul1(bf2f_hi(v_.y), w_)); \
            o_.z = pk2(fmul1(bf2f(v_.z & 0xffffu), w_), fmul1(bf2f_hi(v_.z), w_)); o_.w = pk2(fmul1(bf2f(v_.w & 0xffffu), w_), fmul1(bf2f_hi(v_.w), w_)); \
            *(LAS u32x4*)(XH + q * 8192 + off_b(tt >> 3, 8 + (tt & 7))) = o_; } } while (0)
#define SSD_LD_C(base_, cf_) do { const bf16_t* cp_ = (const bf16_t*)(SSD_PB(base_) + (__umul24(SSD_TL(32 * i + l31), (unsigned)(PJ * 2)) + (unsigned)((PJ_C + g * DSTATE + 8 * h) * 2))); \
            _Pragma("unroll") for (int s_ = 0; s_ < 8; ++s_) cf_[s_] = *(const bf16x8*)(cp_ + 16 * s_); } while (0)
#define SSD_TABLES(T, d0_, d1_) do { \
            const float dt0 = softplus_f(d0_ + dbias), dt1 = softplus_f(d1_ + dbias); float v0 = dt0 * Aneg, v1 = dt1 * Aneg; \
            _Pragma("unroll") for (int o = 1; o < 64; o <<= 1) { const float t0 = shup(v0, o, lane), t1 = shup(v1, o, lane); if (lane >= o) { v0 += t0; v1 += t1; } } \
            const float tot0 = rdl(v0, 63); v1 += tot0; const float E0 = rdl(v0, 31), E2 = rdl(v1, 31), E3 = rdl(v1, 63); \
            const float eb0 = lane < 32 ? E0 : tot0, eb1 = lane < 32 ? E2 : E3; \
            T[T_ACUM / 4 + lane] = v0; T[T_ACUM / 4 + 64 + lane] = v1; T[T_DT / 4 + lane] = dt0; T[T_DT / 4 + 64 + lane] = dt1; \
            T[T_RF / 4 + lane] = dt0 * __expf(eb0 - v0); T[T_RF / 4 + 64 + lane] = dt1 * __expf(eb1 - v1); \
            T[T_W / 4 + lane] = dt0 * __expf(E3 - v0); T[T_W / 4 + 64 + lane] = dt1 * __expf(E3 - v1); \
            T[T_EAC / 4 + lane] = __expf(v0); T[T_EAC / 4 + 64 + lane] = __expf(v1); \
            if (lane == 0) { T[T_E / 4 + 0] = E0; T[T_E / 4 + 1] = tot0; T[T_E / 4 + 2] = E2; T[T_E / 4 + 3] = E3; } } while (0)
#define SSD_LD_DT(base_, d0_, d1_) do { if (tabwave) { const char* db_ = (const char*)dtb + (size_t)(base_) * (NDT * 4) + (d * NH + head) * 4; d0_ = *(const float*)(db_ + __umul24(SSD_TL(lane), (unsigned)(NDT * 4))); d1_ = *(const float*)(db_ + __umul24(SSD_TL(lane + 64), (unsigned)(NDT * 4))); } } while (0)
        int base = SSD_BASE(0);
        u32x4 br[4], xr[2]; bf16x8 cf[8]; float dr0 = 0.f, dr1 = 0.f;
        { float d00 = 0.f, d01 = 0.f; SSD_LD_DT(base, d00, d01); SSD_LD_B(base, 0, br); SSD_LD_X(base, 0, xr); SSD_LD_C(base, cf);
          { const int b1_ = SSD_BASE(1); SSD_LD_DT(b1_, dr0, dr1); }
          if (tabwave) { LAS float* T0 = (LAS float*)(lb + OFF_TAB); SSD_TABLES(T0, d00, d01); } }
        __syncthreads();
        for (int k = 0; k < NCHUNK; ++k) {
#define SSD_RELANE() do { lane = opaque_i(lane0); tt = wi * 64 + lane; h = lane >> 5; l31 = lane & 31; tq = (lane & 15) >> 2; tp = lane & 3; tblk = (lane >> 4) & 1; } while (0)
            SSD_RELANE();
            const int nbase = (k + 1 < NCHUNK) ? SSD_BASE(k + 1) : base;
            LAS unsigned char* TAB = lb + OFF_TAB + (k & 1) * TABSZ;
            const int n2base = (k + 2 < NCHUNK) ? SSD_BASE(k + 2) : nbase;
            SSD_ST_B(br); SSD_ST_X(xr);
            SSD_ST_XW(0, xr);
            SSD_LD_B(base, 1, br); SSD_LD_X(base, 1, xr);
            const unsigned lbase = las_int(lb);
            unsigned LBt = lbase + off_b(l31, h);
            f32x16 ya[2];
#pragma unroll
            for (int r = 0; r < 16; ++r) { ya[0][r] = 0.f; ya[1][r] = 0.f; }
#pragma unroll
            for (int s_ = 0; s_ < 8; ++s_)
#pragma unroll
                for (int pt = 0; pt < 2; ++pt) { const bf16x8 sb = *(const LAS bf16x8*)las_ptr((LBt ^ (unsigned)(s_ << 5)) + OFF_SIMG + pt * 8192); ya[pt] = MFMA32(cf[s_], sb, ya[pt]); }
            {
                const float eend = __expf(*(LAS float*)(TAB + T_E + 12));
#pragma unroll
                for (int q = 0; q < 4; ++q) { const f32x4 ea = *(LAS f32x4*)(TAB + T_EAC + (32 * i + 8 * q + 4 * h) * 4);
#pragma unroll
                    for (int e = 0; e < 4; ++e) { ya[0][4 * q + e] = fmul1(ya[0][4 * q + e], ea[e]); ya[1][4 * q + e] = fmul1(ya[1][4 * q + e], ea[e]); } }
#pragma unroll
                for (int r = 0; r < 16; ++r) { st[0][r] = fmul1(st[0][r], eend); st[1][r] = fmul1(st[1][r], eend); }
            }
            const float al = *(LAS float*)(TAB + T_ACUM + (32 * i + l31) * 4);
            __syncthreads();
            SSD_RELANE();
#define SSD_TILE_BASES() do { const unsigned c2_ = 2u * tblk + (tp >> 1), o8_ = 8u * (tp & 1); LBt = lbase + off_b(l31, h); \
                GXt = lbase + off_b(4 * h + tq, c2_) + o8_; UBt = lbase + off_b(8 * h + tq, 4 * nb + c2_) + o8_; XWt = lbase + off_b(8 * h + tq, 8 + c2_) + o8_; } while (0)
            unsigned GXt, UBt, XWt;
            SSD_TILE_BASES();
#pragma unroll
            for (int hh = 0; hh < 2; ++hh) {
                if (hh == 1) {
                    __syncthreads();
                    SSD_ST_B(br); SSD_ST_X(xr); SSD_ST_XW(1, xr);
                    if (k + 1 < NCHUNK) { SSD_LD_B(nbase, 0, br); SSD_LD_X(nbase, 0, xr); }
                    __syncthreads();
                    SSD_RELANE();
                    SSD_TILE_BASES();
                    if (tabwave) { LAS float* Tn = (LAS float*)(lb + OFF_TAB + ((k + 1) & 1) * TABSZ); SSD_TABLES(Tn, dr0, dr1); }
                    SSD_LD_DT(n2base, dr0, dr1);
                }
#pragma unroll
                for (int jj = 0; jj < 2; ++jj) {
                    const int j = 2 * hh + jj;
                    LAS unsigned char* bt = BH + jj * 8192; LAS unsigned char* xt = XH + jj * 8192;
                    if (j <= i) {
                        f32x16 cb;
#pragma unroll
                        for (int r = 0; r < 16; ++r) cb[r] = 0.f;
#pragma unroll
                        for (int s_ = 0; s_ < 8; ++s_) { const bf16x8 ba = *(const LAS bf16x8*)las_ptr((LBt ^ (unsigned)(s_ << 5)) + OFF_BH + jj * 8192); cb = MFMA32(ba, cf[s_], cb); }
                        bf16x8 xb0[2];
#pragma unroll
                        for (int pt = 0; pt < 2; ++pt)
                            xb0[pt] = trpair(las_ptr((GXt ^ (unsigned)(64 * pt)) + OFF_XH + jj * 8192), las_ptr((GXt ^ (unsigned)(64 * pt) ^ 32u) + 2048 + OFF_XH + jj * 8192));
                        if (j < i) {
                            const float fl = __expf(al - *(LAS float*)(TAB + T_E + j * 4));
#pragma unroll
                            for (int q = 0; q < 4; ++q) { const f32x4 rf = *(LAS f32x4*)(TAB + T_RF + (32 * j + 8 * q + 4 * h) * 4);
#pragma unroll
                                for (int e = 0; e < 4; ++e) cb[4 * q + e] = fmul1(cb[4 * q + e], fmul1(rf[e], fl)); }
                        } else {
#pragma unroll
                            for (int q = 0; q < 4; ++q) { const f32x4 as = *(LAS f32x4*)(TAB + T_ACUM + (32 * j + 8 * q + 4 * h) * 4), ds = *(LAS f32x4*)(TAB + T_DT + (32 * j + 8 * q + 4 * h) * 4);
#pragma unroll
                                for (int e = 0; e < 4; ++e) { const int sl = 8 * q + 4 * h + e; float v = fmul1(fmul1(cb[4 * q + e], ds[e]), __expf(fminf(al - as[e], 0.f)));
                                    v = sl <= l31 ? v : 0.f; v += sl == l31 ? dskip : 0.f; cb[4 * q + e] = v; } }
                        }
#pragma unroll
                        for (int ks = 0; ks < 2; ++ks) {
                            f32x8 gv;
#pragma unroll
                            for (int e = 0; e < 8; ++e) gv[e] = cb[8 * ks + e];
                            const bf16x8 ga = __builtin_bit_cast(bf16x8, __builtin_convertvector(gv, bf16v8));
#pragma unroll
                            for (int pt = 0; pt < 2; ++pt) {
                                const bf16x8 xb = ks == 0 ? xb0[pt] : trpair(las_ptr((GXt ^ (unsigned)(64 * pt)) + 4096 + OFF_XH + jj * 8192), las_ptr((GXt ^ (unsigned)(64 * pt) ^ 32u) + 4096 + 2048 + OFF_XH + jj * 8192));
                                ya[pt] = MFMA32(ga, xb, ya[pt]); }
                        }
                    }
#pragma unroll
                    for (int ks = 0; ks < 2; ++ks) {
                        const bf16x8 ab = trpair(las_ptr(UBt + 4096 * ks + OFF_BH + jj * 8192), las_ptr((UBt ^ 16u) + 1024 + 4096 * ks + OFF_BH + jj * 8192));
#pragma unroll
                        for (int pt = 0; pt < 2; ++pt) {
                            const bf16x8 xw = trpair(las_ptr((XWt ^ (unsigned)(64 * pt)) + 4096 * ks + OFF_XH + jj * 8192), las_ptr((XWt ^ (unsigned)(64 * pt) ^ 16u) + 1024 + 4096 * ks + OFF_XH + jj * 8192));
                            st[pt] = MFMA32(ab, xw, st[pt]); }
                    }
                }
            }
            const int rbase = base;
            if (k + 1 < NCHUNK) { base = nbase; SSD_LD_C(base, cf); }
            SSD_RELANE();
            const bool first_vis = (k == 0 || (k >= 2 && k <= 9));
            u32x4 sv[4];
            if (!first_vis) {
#pragma unroll
                for (int q = 0; q < 4; ++q) { const int e = tt + 256 * q, l = e >> 3, ch = e & 7; sv[q] = *(const u32x4*)(SSD_SB(rbase) + (__umul24(SSD_TL(l), (unsigned)(DSSD * 2)) + (unsigned)((head * HD + ch * 8) * 2))); }
            }
            const unsigned FBt = lbase + off_b(l31, 4 * nb) + 8 * h;
#pragma unroll
            for (int pt = 0; pt < 2; ++pt)
#pragma unroll
                for (int q = 0; q < 4; ++q) { u32x2 o; o.x = pk2(st[pt][4 * q], st[pt][4 * q + 1]); o.y = pk2(st[pt][4 * q + 2], st[pt][4 * q + 3]);
                    *(LAS u32x2*)las_ptr((FBt ^ (unsigned)(16 * q)) + OFF_SIMG + pt * 8192) = o; }
#pragma unroll
            for (int pt = 0; pt < 2; ++pt)
#pragma unroll
                for (int r2 = 0; r2 < 8; ++r2) { const unsigned v = pk2(ya[pt][2 * r2], ya[pt][2 * r2 + 1]);
                    *(LAS bf16_t*)(YST + ((32 * i + crow(2 * r2, h)) * 64 + 32 * pt + l31) * 2) = (bf16_t)(v & 0xffffu);
                    *(LAS bf16_t*)(YST + ((32 * i + crow(2 * r2 + 1, h)) * 64 + 32 * pt + l31) * 2) = (bf16_t)(v >> 16); }
            __syncthreads();
            SSD_RELANE();
            if (first_vis) {
#pragma unroll
                for (int q = 0; q < 4; ++q) { const int e = tt + 256 * q, l = e >> 3, ch = e & 7;
                    *(u32x4*)(SSD_SB(rbase) + (__umul24(SSD_TL(l), (unsigned)(DSSD * 2)) + (unsigned)((head * HD + ch * 8) * 2))) = *(LAS u32x4*)(YST + l * 128 + ch * 16); }
            } else {
#pragma unroll
                for (int q = 0; q < 4; ++q) { const int e = tt + 256 * q, l = e >> 3, ch = e & 7;
                    const u32x4 yv = *(LAS u32x4*)(YST + l * 128 + ch * 16), s4 = sv[q]; u32x4 o;
                    o.x = pk2(fadd1(bf2f(yv.x & 0xffffu), bf2f(s4.x & 0xffffu)), fadd1(bf2f_hi(yv.x), bf2f_hi(s4.x))); o.y = pk2(fadd1(bf2f(yv.y & 0xffffu), bf2f(s4.y & 0xffffu)), fadd1(bf2f_hi(yv.y), bf2f_hi(s4.y)));
                    o.z = pk2(fadd1(bf2f(yv.z & 0xffffu), bf2f(s4.z & 0xffffu)), fadd1(bf2f_hi(yv.z), bf2f_hi(s4.z))); o.w = pk2(fadd1(bf2f(yv.w & 0xffffu), bf2f(s4.w & 0xffffu)), fadd1(bf2f_hi(yv.w), bf2f_hi(s4.w)));
                    bf16_t* sp_ = (bf16_t*)(SSD_SB(rbase) + (__umul24(SSD_TL(l), (unsigned)(DSSD * 2)) + (unsigned)((head * HD + ch * 8) * 2)));
                    if (k == 1) ST16_WT(sp_, o);
                    else *(u32x4*)sp_ = o; }
            }
            if (k == 1) cnt_signal_wt((unsigned*)(p.ws + WS_CTL) + CW_CTXDONE, p.wv);
        }
    }
#undef SSD_RELANE
#undef SSD_TILE_BASES
#undef SSD_BASE
#undef SSD_ROW
#undef SSD_TL
#undef SSD_PB
#undef SSD_SB
#undef SSD_LD_B
#undef SSD_ST_B
#undef SSD_LD_X
#undef SSD_ST_X
#undef SSD_ST_XW
#undef SSD_LD_C
#undef SSD_LD_DT
#undef SSD_TABLES
}

}

__device__ __forceinline__ void ph_gnorm(const Params& p, int layer, int row_lo, int row_hi, int bid, int G) {
    const int tid = TIDX, lane = tid & 63; const int gw = bid * 8 + (tid >> 6), NGW = G * 8;
    bf16_t* proj = (bf16_t*)(p.ws + WS_PROJ); const float* nw = p.ssd_norm_w + layer * DSSD;
    const bf16_t* ysum = (const bf16_t*)(p.ws + WS_STASH);
    constexpr int RB = 3;
    if (bid < 0) return;
    for (int r0 = row_lo + gw * RB; r0 < row_hi; r0 += NGW * RB) {
        u32x4 v[RB][3]; float gs[RB][4];
#pragma unroll
        for (int u = 0; u < RB; ++u)
#pragma unroll
            for (int j = 0; j < 3; ++j) { const size_t rw = (size_t)(r0 + u < row_hi ? r0 + u : row_hi - 1);
                const u32x4 y = *(const u32x4*)(ysum + rw * DSSD + (lane + 64 * j) * 8), z = *(const u32x4*)(proj + rw * PJ + PJ_ZS + (lane + 64 * j) * 8);
                u32x4 gq;
                gq.x = pk2(bf2f(y.x & 0xffffu) * silu_f(bf2f(z.x & 0xffffu)), bf2f_hi(y.x) * silu_f(bf2f_hi(z.x))); gq.y = pk2(bf2f(y.y & 0xffffu) * silu_f(bf2f(z.y & 0xffffu)), bf2f_hi(y.y) * silu_f(bf2f_hi(z.y)));
                gq.z = pk2(bf2f(y.z & 0xffffu) * silu_f(bf2f(z.z & 0xffffu)), bf2f_hi(y.z) * silu_f(bf2f_hi(z.z))); gq.w = pk2(bf2f(y.w & 0xffffu) * silu_f(bf2f(z.w & 0xffffu)), bf2f_hi(y.w) * silu_f(bf2f_hi(z.w)));
                v[u][j] = gq; }
#pragma unroll
        for (int u = 0; u < RB; ++u) { float ss[3];
#pragma unroll
            for (int j = 0; j < 3; ++j) { const unsigned w4[4] = {v[u][j].x, v[u][j].y, v[u][j].z, v[u][j].w}; float a = 0.f;
#pragma unroll
                for (int e = 0; e < 4; ++e) { const float lo = bf2f(w4[e] & 0xffffu), hi = bf2f_hi(w4[e]); a += lo * lo + hi * hi; }
                ss[j] = a; }
#pragma unroll
            for (int g = 0; g < 4; ++g) { float a = 0.f;
#pragma unroll
                for (int j = 0; j < 3; ++j) { const int c = lane + 64 * j; a += (c / 48 == g) ? ss[j] : 0.f; }
                gs[u][g] = a; } }
#pragma unroll
        for (int o = 1; o < 64; o <<= 1) {
#pragma unroll
            for (int u = 0; u < RB; ++u)
#pragma unroll
                for (int g = 0; g < 4; ++g) gs[u][g] += shx(gs[u][g], o, lane); }
#pragma unroll
        for (int u = 0; u < RB; ++u) {
#pragma unroll
            for (int g = 0; g < 4; ++g) gs[u][g] = rsqrtf(gs[u][g] * (1.f / 384.f) + EPS);
#pragma unroll
            for (int j = 0; j < 3; ++j) { const int c = lane + 64 * j, g = c / 48; const float rinv = g == 0 ? gs[u][0] : (g == 1 ? gs[u][1] : (g == 2 ? gs[u][2] : gs[u][3]));
                const f32x4 w0 = *(const f32x4*)(nw + c * 8), w1 = *(const f32x4*)(nw + c * 8 + 4); u32x4 o;
                o.x = pk2(bf2f(v[u][j].x & 0xffffu) * rinv * w0[0], bf2f_hi(v[u][j].x) * rinv * w0[1]); o.y = pk2(bf2f(v[u][j].y & 0xffffu) * rinv * w0[2], bf2f_hi(v[u][j].y) * rinv * w0[3]);
                o.z = pk2(bf2f(v[u][j].z & 0xffffu) * rinv * w1[0], bf2f_hi(v[u][j].z) * rinv * w1[1]); o.w = pk2(bf2f(v[u][j].w & 0xffffu) * rinv * w1[2], bf2f_hi(v[u][j].w) * rinv * w1[3]);
                if (r0 + u < row_hi) *(u32x4*)(proj + (size_t)(r0 + u) * PJ + PJ_ZS + c * 8) = o; } }
    }
}

__device__ __forceinline__ void ph_final(const Params& p, int bid, int G) {
    const int lane = TIDX & 63; const int gw = bid * 8 + (TIDX >> 6), NGW = G * 8;
    f32x4 w[4];
#pragma unroll
    for (int j = 0; j < 4; ++j) w[j] = *(const f32x4*)(p.final_norm_w + j * 256 + lane * 4);
    constexpr int RB = 2;
    for (int row = gw * RB; row < MLAT; row += NGW * RB) {
        float* src = p.out + (size_t)row * DM;
        f32x4 v[RB][4]; float ss[RB];
#pragma unroll
        for (int u = 0; u < RB; ++u)
#pragma unroll
            for (int j = 0; j < 4; ++j) v[u][j] = *(const f32x4*)(src + (size_t)u * DM + j * 256 + lane * 4);
#pragma unroll
        for (int u = 0; u < RB; ++u) { float a = 0.f;
#pragma unroll
            for (int j = 0; j < 4; ++j) a += v[u][j].x * v[u][j].x + v[u][j].y * v[u][j].y + v[u][j].z * v[u][j].z + v[u][j].w * v[u][j].w;
            ss[u] = a; }
#pragma unroll
        for (int o = 1; o < 64; o <<= 1) {
#pragma unroll
            for (int u = 0; u < RB; ++u) ss[u] += shx(ss[u], o, lane); }
#pragma unroll
        for (int u = 0; u < RB; ++u) { const float rinv = rsqrtf(ss[u] * (1.f / DM) + EPS);
#pragma unroll
            for (int j = 0; j < 4; ++j)
                *(f32x4*)(src + (size_t)u * DM + j * 256 + lane * 4) = (f32x4){v[u][j].x * rinv * w[j].x, v[u][j].y * rinv * w[j].y, v[u][j].z * rinv * w[j].z, v[u][j].w * rinv * w[j].w}; }
    }
}


#define XB_TMO      128
#define XB_XCNT(j)  (256  + 64 * (j))
#define XB_XSUB(j)  (1280 + 64 * (j))
#define XB_XGEN(j)  (2304 + 64 * (j))
#define XB_TOP      3328
#define XB_TOPGEN   3392
#define XCD_BAR_WORDS 3456
#define XB_SPIN_CAP (1u << 18)
__device__ __forceinline__ unsigned xb_ld(unsigned* p)              { return __hip_atomic_load(p, __ATOMIC_RELAXED, __HIP_MEMORY_SCOPE_AGENT); }
__device__ __forceinline__ unsigned xb_add(unsigned* p, unsigned v) { return __hip_atomic_fetch_add(p, v, __ATOMIC_RELAXED, __HIP_MEMORY_SCOPE_AGENT); }
__device__ __forceinline__ unsigned xb_xcc_id() { return (unsigned)__builtin_amdgcn_s_getreg((3 << 11) | 20) & 0xFu; }
#define XB_SPIN(cond, bar) do { unsigned _sp = 0; while (cond) { __builtin_amdgcn_s_sleep(1); \
    if ((++_sp & 255u) == 0u) { if (xb_ld(&(bar)[XB_TMO])) break; if (_sp > XB_SPIN_CAP) { atomicAdd(&(bar)[XB_TMO], 1u); break; } } } } while (0)
struct XcdBarrier { unsigned* bar; unsigned x; volatile __attribute__((address_space(3))) unsigned* st; int wv; };
__device__ __forceinline__ XcdBarrier xcd_barrier_post(unsigned* bar, volatile __attribute__((address_space(3))) unsigned* st, int wv) {
    XcdBarrier b; b.bar = bar; b.x = xb_xcc_id(); b.st = st; b.wv = wv;
    if (wv == 0 && lane_id() == 0) (void)xb_add(&bar[XB_XCNT(b.x)], 1u);
    return b;
}
__device__ __forceinline__ void xcd_barrier_complete(unsigned* bar, unsigned x, unsigned& nloc, unsigned& nx) {
    const unsigned G = gridDim.x * gridDim.y * gridDim.z;
    unsigned sum, cnt, mine, sp = 0u;
    for (;;) {
        sum = 0u; cnt = 0u; mine = 0u;
#pragma unroll
        for (unsigned j = 0; j < 16; ++j) { const unsigned c = xb_ld(&bar[XB_XCNT(j)]); sum += c; cnt += (c > 0u) ? 1u : 0u; mine = (j == x) ? c : mine; }
        if (sum == G) break;
        __builtin_amdgcn_s_sleep(1);
        if ((++sp & 255u) == 0u) { if (xb_ld(&bar[XB_TMO])) break; if (sp > XB_SPIN_CAP) { atomicAdd(&bar[XB_TMO], 1u); break; } }
    }
    nloc = mine > 0u ? mine : 1u; nx = cnt > 0u ? cnt : 1u;
}
__device__ __forceinline__ void xcd_barrier(const XcdBarrier& b) {
    asm volatile("s_waitcnt vmcnt(0)" ::: "memory");
    __syncthreads();
    if (b.wv == 0 && lane_id() == 0) {
        unsigned* bar = b.bar;
        __builtin_amdgcn_s_waitcnt(0);
        unsigned nloc = b.st[0], nx = b.st[1];
        if (nloc == 0u) { xcd_barrier_complete(bar, b.x, nloc, nx); b.st[0] = nloc; b.st[1] = nx; }
        const unsigned old = xb_add(&bar[XB_XSUB(b.x)], 1u);
        const unsigned gen = old / nloc;
        if (old + 1u == (gen + 1u) * nloc) {
            __builtin_amdgcn_fence(__ATOMIC_RELEASE, "agent");
            asm volatile("s_waitcnt vmcnt(0)" ::: "memory");
            const unsigned og = xb_add(&bar[XB_TOP], 1u);
            const unsigned tg = og / nx;
            if (og + 1u == (tg + 1u) * nx) xb_add(&bar[XB_TOPGEN], 1u);
            else XB_SPIN(xb_ld(&bar[XB_TOPGEN]) == tg, bar);
            __builtin_amdgcn_fence(__ATOMIC_ACQUIRE, "agent");
            xb_add(&bar[XB_XGEN(b.x)], 1u);
            asm volatile("s_waitcnt vmcnt(0)" ::: "memory");
        } else {
            XB_SPIN(xb_ld(&bar[XB_XGEN(b.x)]) == gen, bar);
            __builtin_amdgcn_fence(__ATOMIC_ACQUIRE, "agent");
            asm volatile("s_waitcnt vmcnt(0)" ::: "memory");
        }
    }
    __syncthreads();
}

constexpr int NSUB = 6;
constexpr int NPHASE = 2 + NSUB * DEPTH;
__global__ void __launch_bounds__(NT, 2) mega(Params p) {
    extern __shared__ __attribute__((aligned(16))) unsigned char smem[];
    cg::grid_group grid = cg::this_grid();
    const int bid = blockIdx.x, G = gridDim.x;
    volatile __attribute__((address_space(3))) unsigned* lds_st = (volatile __attribute__((address_space(3))) unsigned*)((__attribute__((address_space(3))) unsigned char*)smem + LDS_BYTES - 64);
    const int wv = __builtin_amdgcn_readfirstlane((int)threadIdx.x >> 6);
    if (wv == 0 && lane_id() < 16) lds_st[lane_id()] = 0u;
    __syncthreads();
    const XcdBarrier xbar = xcd_barrier_post((unsigned*)(p.ws + WS_CTL), lds_st, wv);
    const bool fuse = __builtin_amdgcn_readfirstlane(p.fuse_final) != 0;
    for (int ph = p.ph_lo; ph < p.ph_hi; ++ph) {
        Params q = p; q.wv = wv;
#define fgemm_all(...) fgemm_all_(q.wv, __VA_ARGS__)
        unsigned char* ws = q.ws;
        bf16_t* H = (bf16_t*)(ws + WS_H); bf16_t* PQ = H; bf16_t* PROJ = (bf16_t*)(ws + WS_PROJ); bf16_t* UT = (bf16_t*)(ws + WS_UT); float* DT = (float*)(ws + WS_DT);
        bf16_t* W1 = (bf16_t*)(ws + WS_W1); bf16_t* WU = (bf16_t*)(ws + WS_WU); bf16_t* WO = (bf16_t*)(ws + WS_WO); bf16_t* WF = (bf16_t*)(ws + WS_WF);
        bf16_t* DFT = (bf16_t*)(ws + WS_DFT); bf16_t* DFTC = (bf16_t*)(ws + WS_DFTC);
        float* XC = (float*)(ws + WS_XC); const float* MOD = (const float*)(ws + WS_MOD);
        if (ph == 0) { ph_mod(q, smem, bid, G); ph_dftgen(q, (bid + G - 192) % G, G); ph_convert(q, smem, 0, 5, (bid + 144) % G, G); }
        else if (ph == NPHASE - 1) { ph_final(q, bid, G); }
        else {
            const int i = (ph - 1) / NSUB, sub = (ph - 1) % NSUB;
            if (sub == 0 && i > 0 && fuse) continue;
            if (sub == 0) { ph_norm(q, i, bid, G); }
            else if (sub == 1) {
                int first = fgemm_all(smem, H, DM, W1, DM, MTOT, N1, DM, pg8::EpiProj{PROJ, DT}, 0, bid, G);
                fgemm_all(smem, WU, DM, H, DM, 512, MTOT, DM, pg8::EpiUt{UT}, first, bid, G);
            } else if (sub == 2) {
                ph_conv(q, smem, i, 0, 16 * 80, bid, G);
                ph_convert(q, smem, i, 2, bid, G);
                if (i + 1 < DEPTH) ph_convert(q, smem, i + 1, 1, (bid + G - 128) % G, G);
            } else if (sub == 3) {
                const int nI = NB * NH;
                ssd::ph_ssd(q, smem, i, bid, G);
                { const int cb_ = G > nI ? bid - nI : bid, cg_ = G > nI ? G - nI : G;
                  if (cb_ >= 0) {
                      int first = fgemm_all(smem, DFT, SEQ, UT, SEQ, SEQ, NB * 512, SEQ, pg8::EpiPQ{PQ, 0, SEQ, 0.00276213586f  }, 0, cb_, cg_);
                      fgemm_all(smem, DFTC, CTXL, UT + (size_t)NB * 512 * SEQ, CTXL, CTXL, NB * 512, CTXL, pg8::EpiPQ{PQ, MLAT, CTXL, 0.0078125f  }, cg_ >= 64 ? 32 : first, cb_, cg_);
                      ph_dft_row0(q, cb_ * 8 + q.wv, cg_ * 8);
                      if (i + 1 < DEPTH && G > nI) {
                          unsigned* ctl = (unsigned*)(q.ws + WS_CTL);
                          cnt_signal(ctl + CW_IDLE, q.wv);
                          if (cg_ >= 64) ph_convert(q, smem, i + 1, 4, cb_ >= 16 ? cb_ - 16 : -1, cg_ - 16); else ph_convert(q, smem, i + 1, 4, cb_, cg_);
                          cnt_wait(ctl + CW_IDLE, (unsigned)(cg_ * (i + 1)), q.wv);
                          fgemm_all(smem, PQ, 1024, WF + (size_t)(i & 1) * 512 * 1024, 1024, MCTX, 512, 1024, pg8::EpiFl{PROJ, q.b_fourier + i * 512}, 0, cb_, cg_, MLAT);
                          cnt_wait(ctl + CW_CTXDONE, (unsigned)(nI * (i + 1)), q.wv);
                          ph_gnorm(q, i, MLAT, MTOT, (cb_ + cg_ - 16) % cg_, cg_);
                      }
                  } }
            }
            else if (sub == 4) {
                if (i + 1 < DEPTH && G <= NB * NH) {
                    ph_convert(q, smem, i + 1, 4, bid, G);
                    fgemm_all(smem, PQ, 1024, WF + (size_t)(i & 1) * 512 * 1024, 1024, MCTX, 512, 1024, pg8::EpiFl{PROJ, q.b_fourier + i * 512}, 0, bid, G, MLAT);
                    ph_gnorm(q, i, MLAT, MTOT, bid, G);
                    xcd_barrier(xbar);
                }
                const int nctx = (i + 1 < DEPTH) ? (MCTX / 256) * (DM / 256) : 0;
                const bool split = nctx > 0 && nctx < G;
                const int ob = split ? (bid < nctx ? bid : -1) : bid, og = split ? nctx : G;
                const int lb_ = split ? (bid >= nctx ? bid - nctx : -1) : bid, lg = split ? G - nctx : G;
                if (nctx > 0) {
                    if (fuse) fgemm_all(smem, PROJ, PJ, WO, 2048, MCTX, DM, 2048, pg8::EpiOutNorm{i == 0 ? q.x : q.out, q.out, i == 0 ? q.ctx : XC, XC, MOD + (size_t)i * 9 * 3072,
                        q.norm_w + (i + 1) * DM, MOD + (size_t)(i + 1) * 9 * 3072, H, (float*)(ws + WS_RSQ), (unsigned*)(ws + WS_CTL) + CW_PANEL, 4u * (unsigned)(i + 1)}, 0, ob, og, MLAT);
                    else fgemm_all(smem, PROJ, PJ, WO, 2048, MCTX, DM, 2048, pg8::EpiOut{i == 0 ? q.x : q.out, q.out, i == 0 ? q.ctx : XC, XC, MOD + (size_t)i * 9 * 3072}, 0, ob, og, MLAT); }
                fgemm_all(smem, PQ, 1024, WF + (size_t)(i & 1) * 512 * 1024, 1024, MLAT, 512, 1024, pg8::EpiFl{PROJ, q.b_fourier + i * 512}, 0, lb_, lg, 0);
                ph_gnorm(q, i, 0, MLAT, lb_ < 0 ? -1 : (lb_ + lg - 128 % lg) % lg, lg);
            } else {
                if (i + 1 == DEPTH && fuse)
                    fgemm_all(smem, PROJ, PJ, WO, 2048, MLAT, DM, 2048, pg8::EpiOutFin{q.out, q.out, MOD + (size_t)i * 9 * 3072, q.final_norm_w, (float*)(ws + WS_RSQ), (unsigned*)(ws + WS_CTL) + CW_PANEL, 4u * (unsigned)(i + 1)}, 0, bid, G, 0);
                else if (fuse)
                    fgemm_all(smem, PROJ, PJ, WO, 2048, MLAT, DM, 2048, pg8::EpiOutNorm{i == 0 ? q.x : q.out, q.out, i == 0 ? q.ctx : XC, XC, MOD + (size_t)i * 9 * 3072,
                        q.norm_w + (i + 1) * DM, MOD + (size_t)(i + 1) * 9 * 3072, H, (float*)(ws + WS_RSQ), (unsigned*)(ws + WS_CTL) + CW_PANEL, 4u * (unsigned)(i + 1)}, 0, bid, G, 0);
                else
                fgemm_all(smem, PROJ, PJ, WO, 2048, MLAT, DM, 2048, pg8::EpiOut{i == 0 ? q.x : q.out, q.out, i == 0 ? q.ctx : XC, XC, MOD + (size_t)i * 9 * 3072}, 0, bid, G, 0);
            }
        }
        if (ph + 1 < p.ph_hi) { if (ph == p.ph_lo) grid.sync(); else xcd_barrier(xbar); }
    }
}

#undef fgemm_all
extern "C" void kernel_launch(void* const* d_in, const int* in_sizes, int n_in, void* d_out, int out_size, void* d_ws, size_t ws_size, hipStream_t stream) {
    static int grid = 0;
    if (grid == 0) {
        if (n_in != 18 || ws_size < WS_END || out_size != MLAT * DM) { fprintf(stderr, "kernel_launch: unexpected shapes (n_in %d, ws %zu need %zu, out %d)\n", n_in, ws_size, (size_t)WS_END, out_size); grid = -1; return; }
        int dev = 0, cus = 0, per_cu = 0;
        (void)hipGetDevice(&dev); (void)hipDeviceGetAttribute(&cus, hipDeviceAttributeMultiprocessorCount, dev);
        if (hipFuncSetAttribute((const void*)mega, hipFuncAttributeMaxDynamicSharedMemorySize, LDS_BYTES) != hipSuccess) { fprintf(stderr, "kernel_launch: hipFuncSetAttribute failed\n"); grid = -1; return; }
        if (hipOccupancyMaxActiveBlocksPerMultiprocessor(&per_cu, (const void*)mega, NT, LDS_BYTES) != hipSuccess || per_cu < 1) { fprintf(stderr, "kernel_launch: occupancy query says %d\n", per_cu); grid = -1; return; }
        grid = cus;
    }
    if (grid < 0) return;
    Params p{};
    const float** f = (const float**)&p;
    for (int i = 0; i < 18; ++i) f[i] = (const float*)d_in[i];
    p.out = (float*)d_out; p.ws = (unsigned char*)d_ws; p.ph_lo = 0;
    p.fuse_final = (DEPTH > 1 && grid >= (MLAT / 256) * (DM / 256)) ? 1 : 0;
    p.ph_hi = NPHASE - p.fuse_final;
    if (hipMemsetAsync((char*)d_ws + WS_CTL, 0, 65536, stream) != hipSuccess) { fprintf(stderr, "kernel_launch: memset of control words failed\n"); return; }
    void* args[] = {&p};
    hipError_t e = hipLaunchCooperativeKernel((const void*)mega, dim3(grid), dim3(NT), args, LDS_BYTES, stream);
    if (e != hipSuccess) fprintf(stderr, "kernel_launch: cooperative launch failed: %s (grid %d)\n", hipGetErrorString(e), grid);
}
```

```cpp
#include <hip/hip_runtime.h>
#include <hip/hip_cooperative_groups.h>
#include <cstdio>
#include <cstdint>
#include <type_traits>
namespace cg = cooperative_groups;

typedef unsigned short bf16_t;
typedef short bf16x8 __attribute__((ext_vector_type(8)));
typedef float f32x4 __attribute__((ext_vector_type(4)));
typedef unsigned u32x4 __attribute__((ext_vector_type(4)));
typedef unsigned u32x2 __attribute__((ext_vector_type(2)));

constexpr int DM = 1024, NB = 8, SEQ = 2048, DEPTH = 4, CTXL = 256, GRIDW = 64;
constexpr int DF = 512, DSSD = 1536, NH = 24, NG = 4, HPG = 6, DSTATE = 128, HD = 64;
constexpr int CONVCH = 2560, DPROJ = 5168;
constexpr int MLAT = NB * SEQ, MCTX = NB * CTXL, MTOT = MLAT + MCTX;
constexpr int PJ = 4608;
constexpr int PJ_ZF = 0, PJ_ZS = 512, PJ_XS = 2048, PJ_B = 3584, PJ_C = 4096;
constexpr int N1 = 4864;
constexpr int NDT = 48;
constexpr float EPS = 1e-6f;
constexpr int NT = 512;
constexpr int LDS_BYTES = 147456 + 1024;

constexpr size_t al256(size_t x) { return (x + 255) & ~(size_t)255; }
constexpr size_t WS_CTL  = 0;
constexpr size_t WS_MOD  = 65536;
constexpr size_t WS_XC   = al256(WS_MOD + (size_t)DEPTH * 9 * 3072 * 4);
constexpr size_t WS_H    = al256(WS_XC + (size_t)MCTX * DM * 4);
constexpr size_t WS_STASH= al256(WS_H + (size_t)MTOT * DM * 2);
constexpr size_t WS_PROJ = al256(WS_STASH + (size_t)MTOT * DSSD * 2);
constexpr size_t WS_UT   = al256(WS_PROJ + (size_t)MTOT * PJ * 2);
constexpr size_t WS_DT   = al256(WS_UT + (size_t)MTOT * 512 * 2);
constexpr size_t WS_W1   = al256(WS_DT + (size_t)MTOT * NDT * 4);
constexpr size_t WS_WU   = al256(WS_W1 + (size_t)N1 * DM * 2);
constexpr size_t WS_WO   = al256(WS_WU + (size_t)512 * DM * 2);
constexpr size_t WS_WF   = al256(WS_WO + (size_t)DM * 2048 * 2);
constexpr size_t WS_DFT  = al256(WS_WF + (size_t)2 * 512 * 1024 * 2);
constexpr size_t WS_DFTC = al256(WS_DFT + (size_t)2048 * 2048 * 2);
constexpr size_t WS_RSQ  = al256(WS_DFTC + (size_t)256 * 256 * 2);
constexpr size_t WS_PART = al256(WS_RSQ + (size_t)MTOT * 4 * 4);
constexpr size_t WS_END  = al256(WS_PART + (size_t)32 * 8 * 32 * 256 * 4);
static_assert(WS_END <= (size_t)338690048, "workspace map exceeds 4 x the largest tensor");

struct Params {
    const float *x, *c, *ctx, *c_ctx, *norm_w, *w_ada, *b_ada, *w_in, *conv_w, *conv_b, *dt_bias, *a_log, *d_skip, *ssd_norm_w, *w_fourier, *b_fourier, *w_out, *final_norm_w;
    float* out; unsigned char* ws;
    int ph_lo, ph_hi;
    int wv;
    int fuse_final;
};

typedef __bf16 bf16v2_t __attribute__((ext_vector_type(2)));
typedef float f32x2_t __attribute__((ext_vector_type(2)));
__device__ __forceinline__ unsigned pk2(float lo, float hi) { return __builtin_bit_cast(unsigned, __builtin_convertvector((f32x2_t){lo, hi}, bf16v2_t)); }
__device__ __forceinline__ unsigned f2bf(float f) { return pk2(f, 0.f) & 0xffffu; }
__device__ __forceinline__ float bf2f(unsigned h) { return __builtin_bit_cast(float, h << 16); }
__device__ __forceinline__ float bf2f_hi(unsigned w) { return __builtin_bit_cast(float, w & 0xffff0000u); }
extern "C" __device__ float fmul1(float, float) __asm("llvm.amdgcn.fmul.legacy");
__device__ __forceinline__ float fadd1(float a, float b) { float r; asm("v_add_f32_e32 %0, %1, %2" : "=v"(r) : "v"(a), "v"(b)); return r; }
__device__ __forceinline__ float silu_f(float v) { return v * __builtin_amdgcn_rcpf(1.f + __expf(-v)); }
__device__ __forceinline__ float softplus_f(float v) { return v > 15.f ? v : __logf(1.f + __expf(v)); }
__device__ __forceinline__ int opaque_i(int x) { asm volatile("" : "+v"(x)); return x; }
__device__ __forceinline__ int lane_id() { int l; asm volatile("v_mbcnt_lo_u32_b32 %0, -1, 0\n\tv_mbcnt_hi_u32_b32 %0, -1, %0" : "=v"(l)); return l; }
__device__ __forceinline__ float shx(float v, int o, int lane) { return __int_as_float(__builtin_amdgcn_ds_bpermute((lane ^ o) << 2, __float_as_int(v))); }
__device__ __forceinline__ float shup(float v, int o, int lane) { return __int_as_float(__builtin_amdgcn_ds_bpermute((lane - o) << 2, __float_as_int(v))); }
__device__ __forceinline__ float rdl(float v, int l) { return __int_as_float(__builtin_amdgcn_readlane(__float_as_int(v), l)); }
#define ST16_WT(p_, v_) asm volatile("global_store_dwordx4 %0, %1, off sc1\n\ts_nop 1" :: "v"(p_), "v"(v_) : "memory")
#define ST8_WT(p_, v_)  asm volatile("global_store_dwordx2 %0, %1, off sc1\n\ts_nop 1" :: "v"(p_), "v"(v_) : "memory")
#define TIDX_W(wv_) opaque_i(((wv_) << 6) | lane_id())
#define TIDX TIDX_W(p.wv)
__device__ __forceinline__ float wave_sum(float v, int lane) {
#pragma unroll
    for (int o = 1; o < 64; o <<= 1) v += shx(v, o, lane);
    return v;
}

__device__ __forceinline__ void ph_mod(const Params& p, unsigned char* smem, int bid, int G) {
    float (*s)[DM] = (float (*)[DM])smem;
    float* red = (float*)(smem + 9 * DM * 4);
    const int tid = TIDX, jj = tid & 63, kq = tid >> 6;
    const int nitems = DEPTH * (3072 / 64);
    if (bid >= nitems) return;
    { float cv[18];
#pragma unroll
      for (int q = 0; q < 18; ++q) { const int e = tid + NT * q, r = e / DM, k = e % DM; cv[q] = r < 8 ? p.c[r * DM + k] : p.c_ctx[k]; }
#pragma unroll
      for (int q = 0; q < 18; ++q) { const int e = tid + NT * q; s[e / DM][e % DM] = silu_f(cv[q]); } }
    __syncthreads();
    float* mod = (float*)(p.ws + WS_MOD);
    const int lane = tid & 63, kk = lane >> 4, c4 = lane & 15;
    for (int it = bid; it < nitems; it += G) {
        const int i = it / 48;
        f32x4 acc4[9];
#pragma unroll
        for (int r = 0; r < 9; ++r) acc4[r] = (f32x4){0.f, 0.f, 0.f, 0.f};
        const int kb = kq * 128 + 32 * kk;
        const float* w = p.w_ada + ((size_t)i * DM + kb) * 3072 + (it % 48) * 64 + 4 * c4;
        for (int t0 = 0; t0 < 32; t0 += 8) {
            f32x4 wv[8];
#pragma unroll
            for (int t = 0; t < 8; ++t) wv[t] = *(const f32x4*)(w + (size_t)(t0 + t) * 3072);
#pragma unroll
            for (int r = 0; r < 9; ++r) { const f32x4 sa = *(const f32x4*)&s[r][kb + t0], sb = *(const f32x4*)&s[r][kb + t0 + 4];
                acc4[r] += wv[0] * sa.x + wv[1] * sa.y + wv[2] * sa.z + wv[3] * sa.w + wv[4] * sb.x + wv[5] * sb.y + wv[6] * sb.z + wv[7] * sb.w; } }
#pragma unroll
        for (int o = 16; o < 64; o <<= 1)
#pragma unroll
            for (int r = 0; r < 9; ++r) { acc4[r].x += shx(acc4[r].x, o, lane); acc4[r].y += shx(acc4[r].y, o, lane); acc4[r].z += shx(acc4[r].z, o, lane); acc4[r].w += shx(acc4[r].w, o, lane); }
        if (kk == 0) {
#pragma unroll
            for (int r = 0; r < 9; ++r) *(f32x4*)&red[(kq * 9 + r) * 64 + 4 * c4] = acc4[r]; }

        __syncthreads();
        for (int e = tid; e < 9 * 64; e += NT) { const int r = e / 64, c = e % 64; float v = 0.f;
#pragma unroll
            for (int q = 0; q < 8; ++q) v += red[(q * 9 + r) * 64 + c];
            const int jc = (it % 48) * 64 + c; mod[((size_t)i * 9 + r) * 3072 + jc] = v + p.b_ada[i * 3072 + jc]; }
        __syncthreads();
    }
}

__device__ __forceinline__ void ph_dftgen(const Params& p, int bid, int G) {
    bf16_t* D = (bf16_t*)(p.ws + WS_DFT); bf16_t* Dc = (bf16_t*)(p.ws + WS_DFTC);
    const size_t n1 = (size_t)2048 * 2048 / 2, n2 = (size_t)256 * 256 / 2;
    for (size_t e = (size_t)bid * NT + TIDX; e < n1 + n2; e += (size_t)G * NT) {
        if (e < n1) { const int row = (int)(e / 1024), l = (int)(e % 1024) * 2; const int k = (row & 1023) + 1;
            const float a0 = 2.f * ((k * l) & 2047) / 2048.f, a1 = 2.f * ((k * (l + 1)) & 2047) / 2048.f;
            ((unsigned*)D)[e] = row >= 1024 ? pk2(sinpif(a0), sinpif(a1)) : pk2(cospif(a0), cospif(a1)); }
        else { const size_t e2 = e - n1; const int row = (int)(e2 / 128), l = (int)(e2 % 128) * 2; const int k = (row & 127) + 1;
            const float a0 = 2.f * ((k * l) & 255) / 256.f, a1 = 2.f * ((k * (l + 1)) & 255) / 256.f;
            ((unsigned*)Dc)[e2] = row >= 128 ? pk2(sinpif(a0), sinpif(a1)) : pk2(cospif(a0), cospif(a1)); }
    }
}
__device__ __forceinline__ void ph_dft_row0(const Params& p, int cw, int ncw) {
    const int lane = TIDX & 63; const bf16_t* ut = (const bf16_t*)(p.ws + WS_UT); bf16_t* pq = (bf16_t*)(p.ws + WS_H);
    for (int it = cw * 4; it < NB * 512; it += ncw * 4) {
        u32x4 v[4][4];
#pragma unroll
        for (int u = 0; u < 4; ++u)
#pragma unroll
            for (int q = 0; q < 4; ++q) v[u][q] = *(const u32x4*)(ut + (size_t)(it + u) * SEQ + (lane + 64 * q) * 8);
        float a[4];
#pragma unroll
        for (int u = 0; u < 4; ++u) { float t = 0.f;
#pragma unroll
            for (int q = 0; q < 4; ++q) { const u32x4 w = v[u][q]; t += bf2f(w.x & 0xffffu) + bf2f_hi(w.x) + bf2f(w.y & 0xffffu) + bf2f_hi(w.y) + bf2f(w.z & 0xffffu) + bf2f_hi(w.z) + bf2f(w.w & 0xffffu) + bf2f_hi(w.w); }
            a[u] = t; }
#pragma unroll
        for (int o = 1; o < 64; o <<= 1) {
#pragma unroll
            for (int u = 0; u < 4; ++u) a[u] += shx(a[u], o, lane); }
        if (lane < 4) { const int n = it + lane; const float av = (lane == 0 ? a[0] : lane == 1 ? a[1] : lane == 2 ? a[2] : a[3]) * 0.00276213586f;
            bf16_t* q = pq + (size_t)((n >> 9) * SEQ) * 1024 + (n & 511); q[0] = (bf16_t)f2bf(av); q[512] = 0; }
    }
    for (int it = cw * 4; it < NB * 512; it += ncw * 4) {
        u32x2 v[4];
#pragma unroll
        for (int u = 0; u < 4; ++u) v[u] = *(const u32x2*)(ut + (size_t)NB * 512 * SEQ + (size_t)(it + u) * CTXL + lane * 4);
        float a[4];
#pragma unroll
        for (int u = 0; u < 4; ++u) a[u] = bf2f(v[u].x & 0xffffu) + bf2f_hi(v[u].x) + bf2f(v[u].y & 0xffffu) + bf2f_hi(v[u].y);
#pragma unroll
        for (int o = 1; o < 64; o <<= 1) {
#pragma unroll
            for (int u = 0; u < 4; ++u) a[u] += shx(a[u], o, lane); }
        if (lane < 4) { const int n = it + lane; const float av = (lane == 0 ? a[0] : lane == 1 ? a[1] : lane == 2 ? a[2] : a[3]) * 0.0078125f;
            bf16_t* q = pq + (size_t)(MLAT + (n >> 9) * CTXL) * 1024 + (n & 511); q[0] = (bf16_t)f2bf(av); q[512] = 0; }
    }
}

__device__ __forceinline__ void transpose_wide(const float* src, int ldn, int c0, int nvalid, bf16_t* dst, int K, int tk, int tn, unsigned char* smem, int wv) {
    __attribute__((address_space(3))) float* t = (__attribute__((address_space(3))) float*)((__attribute__((address_space(3))) unsigned char*)smem + 20480);
    const int tid = TIDX_W(wv);
    float v[32];
#pragma unroll
    for (int q = 0; q < 32; ++q) { const int e = tid + NT * q, kk = e >> 8, nn = e & 255, n = tn * 256 + nn; v[q] = (n < nvalid) ? src[(size_t)(tk * 64 + kk) * ldn + c0 + n] : 0.f; }
#pragma unroll
    for (int q = 0; q < 32; ++q) { const int e = tid + NT * q; t[(e >> 8) * 257 + (e & 255)] = v[q]; }
    __syncthreads();
#pragma unroll
    for (int q = 0; q < 4; ++q) { const int e = tid + NT * q, nn = e & 255, c = e >> 8;
        const __attribute__((address_space(3))) float* s = t + (8 * c) * 257 + nn;
        u32x4 o; o.x = pk2(s[0], s[257]); o.y = pk2(s[2 * 257], s[3 * 257]); o.z = pk2(s[4 * 257], s[5 * 257]); o.w = pk2(s[6 * 257], s[7 * 257]);
        *(u32x4*)(dst + (size_t)(tn * 256 + nn) * K + tk * 64 + 8 * c) = o; }
    __syncthreads();
}
__device__ __forceinline__ void ph_convert(const Params& p, unsigned char* smem, int layer, int parts, int bid, int G) {
    float (*t)[65] = (float (*)[65])smem;
    float* cs = (float*)(smem + 64 * 65 * 4); float* sn = cs + 64;
    const float* w_in = p.w_in + (size_t)layer * DM * DPROJ;
    const float* w_out = p.w_out + (size_t)layer * 2048 * DM;
    const float* w_f = p.w_fourier + (size_t)layer * 512 * 512;
    bf16_t* W1 = (bf16_t*)(p.ws + WS_W1); bf16_t* WU = (bf16_t*)(p.ws + WS_WU); bf16_t* WO = (bf16_t*)(p.ws + WS_WO); bf16_t* WF = (bf16_t*)(p.ws + WS_WF) + (size_t)(layer & 1) * 512 * 1024;
    if (bid < 0) return;
    if (TIDX < 64) { cs[TIDX] = cospif(2.f * TIDX / 64.f); sn[TIDX] = sinpif(2.f * TIDX / 64.f); }
    __syncthreads();
    constexpr int T1 = (DM / 64) * (N1 / 256), TO = (2048 / 64) * (DM / 256), TU = (DM / 64) * (512 / 256), TFp = 8 * 8;
    for (int it = bid; it < T1 + TO + TU + TFp; it += G) {
        int r = it;
        { const int cls = r < T1 ? 0 : r < T1 + TO ? 1 : r < T1 + TO + TU ? 0 : 2; if (!((parts >> cls) & 1)) continue; }
        if (r < T1) { transpose_wide(w_in, DPROJ, 512, PJ + NDT, W1, DM, r / (N1 / 256), r % (N1 / 256), smem, p.wv); continue; } r -= T1;
        if (r < TO) { transpose_wide(w_out, DM, 0, DM, WO, 2048, r / (DM / 256), r % (DM / 256), smem, p.wv); continue; } r -= TO;
        if (r < TU) { transpose_wide(w_in, DPROJ, 0, 512, WU, DM, r / 2, r % 2, smem, p.wv); continue; } r -= TU;
        { const int g = r / 8, nb = r % 8, tid = TIDX;
          { float tv[8];
#pragma unroll
            for (int q = 0; q < 8; ++q) { const int e = tid + NT * q; tv[q] = w_f[(size_t)(g * 64 + e / 64) * 512 + nb * 64 + e % 64]; }
#pragma unroll
            for (int q = 0; q < 8; ++q) { const int e = tid + NT * q; t[e / 64][e % 64] = tv[q]; } }
          __syncthreads();
          for (int e = tid; e < 64 * 64; e += NT) { const int m = e % 64, nn = e / 64;
              float ac = 0.f, as = 0.f; int idx = 0;
#pragma unroll 8
              for (int cc = 0; cc < 64; ++cc) { const float tv = t[cc][nn]; ac += tv * cs[idx]; as -= tv * sn[idx]; idx = (idx + m) & 63; }
              bf16_t* wq = WF + (size_t)(nb * 64 + nn) * 1024 + g * 64 + m; wq[0] = (bf16_t)f2bf(ac); wq[512] = (bf16_t)f2bf(as); }
          __syncthreads(); }
    }
}

__device__ __forceinline__ void ph_norm(const Params& p, int layer, int bid, int G) {
    const int tid = TIDX, lane = tid & 63; const int gw = bid * 8 + (tid >> 6), NGW = G * 8;
    const float* mod = (const float*)(p.ws + WS_MOD) + (size_t)layer * 9 * 3072;
    const float* nw = p.norm_w + layer * DM;
    bf16_t* H = (bf16_t*)(p.ws + WS_H);
    constexpr int RB = 3;
    for (int r0 = gw * RB; r0 < MTOT; r0 += NGW * RB) {
        const float* src[RB]; int rr[RB]; f32x4 v[RB][4]; float ss[RB];
#pragma unroll
        for (int u = 0; u < RB; ++u) { const int row = r0 + u;
            if (row < MLAT) { src[u] = (layer == 0 ? p.x : p.out) + (size_t)row * DM; rr[u] = row / SEQ; }
            else { src[u] = (layer == 0 ? p.ctx : (const float*)(p.ws + WS_XC)) + (size_t)(row - MLAT) * DM; rr[u] = 8; } }
#pragma unroll
        for (int u = 0; u < RB; ++u)
#pragma unroll
            for (int j = 0; j < 4; ++j) v[u][j] = *(const f32x4*)(src[u] + j * 256 + lane * 4);
#pragma unroll
        for (int u = 0; u < RB; ++u) { float a = 0.f;
#pragma unroll
            for (int j = 0; j < 4; ++j) a += v[u][j].x * v[u][j].x + v[u][j].y * v[u][j].y + v[u][j].z * v[u][j].z + v[u][j].w * v[u][j].w;
            ss[u] = a; }
#pragma unroll
        for (int o = 1; o < 64; o <<= 1) {
#pragma unroll
            for (int u = 0; u < RB; ++u) ss[u] += shx(ss[u], o, lane); }
#pragma unroll
        for (int u = 0; u < RB; ++u) { const float rinv = rsqrtf(ss[u] * (1.f / DM) + EPS); const float* sh = mod + rr[u] * 3072; const float* sc = sh + 1024;
#pragma unroll
            for (int j = 0; j < 4; ++j) { const int c = j * 256 + lane * 4;
                const f32x4 w = *(const f32x4*)(nw + c), s1 = *(const f32x4*)(sc + c), s0 = *(const f32x4*)(sh + c);
                const float o0 = v[u][j].x * rinv * w.x * (1.f + s1.x) + s0.x, o1 = v[u][j].y * rinv * w.y * (1.f + s1.y) + s0.y;
                const float o2 = v[u][j].z * rinv * w.z * (1.f + s1.z) + s0.z, o3 = v[u][j].w * rinv * w.w * (1.f + s1.w) + s0.w;
                u32x2 o; o.x = pk2(o0, o1); o.y = pk2(o2, o3);
                *(u32x2*)(H + (size_t)(r0 + u) * DM + c) = o; } }
    }
}

constexpr int CW_PARTK = 12928;
constexpr int CW_PANEL = 8320;
namespace pg8 {
#define PG8_LAS __attribute__((address_space(3)))
constexpr int BM = 256, BK = 64, HALF = 128, HTB = HALF * BK * 2  , STAGE_BYTES = 8 * HTB, NXCD = 8, WGM = 8;
constexpr int EPI_LDS = STAGE_BYTES, EPI_WAVE = 2048;
__host__ __device__ __forceinline__ int lds_byte(int r, int c) { const int st = (r >> 4) * 2 + (c >> 5), rr = r & 15, cc = c & 31, ob = rr * 64 + cc * 2; return st * 1024 + (ob ^ (((ob >> 9) & 1) << 5)); }
__host__ __device__ __forceinline__ void stage_rc(int b, int& R, int& C) { const int st = b / 1024, sb = b % 1024, swz = sb ^ (((sb >> 9) & 1) << 5); R = (st >> 1) * 16 + swz / 64; C = (st & 1) * 32 + (swz % 64) / 2; }
__host__ __device__ __forceinline__ int perm32(int rho) { const int n = rho >> 4, i = rho & 15; return 8 * (i >> 2) + 4 * n + (i & 3); }

struct Unit { int pm, pn; };
struct Gemm { const bf16_t* A; const bf16_t* Bt; int lda, ldb, K; };

struct StaticOrder {
    int nM, nN, nwg, G, c, pm0;
    __host__ __device__ void init(int M, int N, int G_, int c_, int pm0_ = 0) { nM = M / BM; nN = N / BM; nwg = nM * nN; G = G_; c = c_; pm0 = pm0_; }
    __host__ __device__ bool next(int i, Unit& u) const {
        const long L = (long)i * G + c; if (L >= nwg) return false;
        int wgid = (int)L; { const int q = nwg / NXCD, r = nwg % NXCD, xcd = wgid % NXCD, off = wgid / NXCD; wgid = (xcd < r ? xcd * (q + 1) : r * (q + 1) + (xcd - r) * q) + off; }
        const int nig = WGM * nN, gid = wgid / nig, fm = gid * WGM, gsz = (nM - fm) < WGM ? (nM - fm) : WGM;
        u.pm = pm0 + fm + ((wgid % nig) % gsz); u.pn = (wgid % nig) / gsz; return true;
    }
};
__device__ __forceinline__ unsigned cvt_pk_bf16(float lo, float hi) { unsigned r; asm volatile("v_cvt_pk_bf16_f32 %0, %1, %2" : "=v"(r) : "v"(lo), "v"(hi)); return r; }

template <class T, class = void> struct has_pre : std::false_type {};
template <class T> struct has_pre<T, std::void_t<decltype(&T::pre)>> : std::true_type {};
template <class Epi>
__device__ __forceinline__ void gemm_phase(PG8_LAS unsigned char* lds, const Gemm g, const StaticOrder& S, const Epi& E, int wv) {
    const int tid = TIDX_W(wv), wid = __builtin_amdgcn_readfirstlane(tid >> 6), lane = tid & 63, wr = wid >> 2, wc = wid & 3, fr = lane & 15, fq = lane >> 4;
    const int K = g.K, nt = K / BK;
    unsigned voffA[2], voffB[2];
#pragma unroll
    for (int i = 0; i < 2; ++i) { int R, C; stage_rc(tid * 16 + i * 8192, R, C); const int Rb = Epi::PERM ? ((R >> 5) * 64 + perm32(R & 31)) : R;
        voffA[i] = (unsigned)(R * g.lda + C) * 2u; voffB[i] = (unsigned)(Rb * g.ldb + C) * 2u; }
    const size_t kstep = (size_t)(BK * 2);
    const size_t hstepA = (size_t)HALF * g.lda * 2, hstepB = (size_t)(Epi::PERM ? 32 : HALF) * g.ldb * 2;
    const size_t tstepA = 2 * hstepA, tstepB = (size_t)BM * g.ldb * 2;
    const unsigned ldsw = (unsigned)wid * 1024u;
    const int aoff = lds_byte(wr * 64 + fr, fq * 8), boff = lds_byte(wc * 32 + fr, fq * 8);
#define PG8_SA(b, h) (((b) * 2 + (h)) * HTB)
#define PG8_SB(b, h) ((4 + (b) * 2 + (h)) * HTB)
#define PG8_STAGE(bufoff, gbase, voff) do { _Pragma("unroll") for (int _i = 0; _i < 2; ++_i) \
        __builtin_amdgcn_global_load_lds((const unsigned*)((const char*)(gbase) + (voff)[_i]), (PG8_LAS unsigned*)(lds + (bufoff) + ldsw + _i * 8192), 16, 0, 0); } while (0)
#define PG8_LDA(dst, b, h) do { _Pragma("unroll") for (int m = 0; m < 4; ++m) _Pragma("unroll") for (int k = 0; k < 2; ++k) dst[m][k] = *(const PG8_LAS bf16x8*)(lds + PG8_SA(b, h) + aoff + m * 2048 + k * 1024); } while (0)
#define PG8_LDB(dst, b, h) do { _Pragma("unroll") for (int n = 0; n < 2; ++n) _Pragma("unroll") for (int k = 0; k < 2; ++k) dst[n][k] = *(const PG8_LAS bf16x8*)(lds + PG8_SB(b, h) + boff + n * 2048 + k * 1024); } while (0)
#define PG8_MMA(ai, bj, At, Bt) do { __builtin_amdgcn_s_setprio(1); _Pragma("unroll") for (int m = 0; m < 4; ++m) _Pragma("unroll") for (int n = 0; n < 2; ++n) _Pragma("unroll") for (int k = 0; k < 2; ++k) \
        acc[ai][bj][m][n] = __builtin_amdgcn_mfma_f32_16x16x32_bf16(Bt[n][k], At[m][k], acc[ai][bj][m][n], 0, 0, 0); __builtin_amdgcn_s_setprio(0); } while (0)
#define PG8_WAIT_V(n) asm volatile("s_waitcnt vmcnt(" #n ")" ::: "memory")
#define PG8_WAIT_L(n) asm volatile("s_waitcnt lgkmcnt(" #n ")" ::: "memory")
#define PG8_BAR __builtin_amdgcn_s_barrier()
#define PG8_SCHED __builtin_amdgcn_sched_barrier(0)
    Unit cur, nxt; int ui = 0;
    if (!S.next(0, cur)) return;
    f32x4 acc[2][2][4][2];
#pragma unroll
    for (int a = 0; a < 2; ++a)
#pragma unroll
        for (int b = 0; b < 2; ++b)
#pragma unroll
            for (int m = 0; m < 4; ++m)
#pragma unroll
                for (int n = 0; n < 2; ++n) acc[a][b][m][n] = (f32x4){0.f, 0.f, 0.f, 0.f};
    bf16x8 At[4][2], B0[2][2], B1[2][2];
    const char* cA = (const char*)g.A + (size_t)cur.pm * tstepA; const char* cB = (const char*)g.Bt + (size_t)cur.pn * tstepB;
    PG8_STAGE(PG8_SB(0, 0), cB, voffB); PG8_STAGE(PG8_SB(0, 1), cB + hstepB, voffB); PG8_STAGE(PG8_SA(0, 0), cA, voffA); PG8_STAGE(PG8_SA(0, 1), cA + hstepA, voffA);
    if (wr == 1) PG8_BAR;
    PG8_WAIT_V(2); PG8_BAR;
    PG8_STAGE(PG8_SB(1, 0), cB + kstep, voffB); PG8_STAGE(PG8_SA(1, 0), cA + kstep, voffA); PG8_STAGE(PG8_SB(1, 1), cB + hstepB + kstep, voffB);
    PG8_WAIT_V(6); PG8_BAR;
    for (;;) {
        const bool has_next = S.next(ui + 1, nxt);
        const char* nA = has_next ? (const char*)g.A + (size_t)nxt.pm * tstepA : cA; const char* nB = has_next ? (const char*)g.Bt + (size_t)nxt.pn * tstepB : cB;
        for (int t = 0; t < nt; t += 2) {
            const bool last = (t == nt - 2);
            const char* a1 = cA + (size_t)(t + 1) * kstep;
            const char* a2 = last ? nA : cA + (size_t)(t + 2) * kstep; const char* b2 = last ? nB : cB + (size_t)(t + 2) * kstep;
            const char* a3 = a2 + kstep; const char* b3 = b2 + kstep;
            PG8_LDB(B0, 0, 0); PG8_LDB(B1, 0, 1); PG8_SCHED; PG8_LDA(At, 0, 0); PG8_STAGE(PG8_SA(1, 1), a1 + hstepA, voffA);
            PG8_WAIT_V(8); PG8_WAIT_L(0); PG8_BAR; PG8_MMA(0, 0, At, B0); PG8_MMA(0, 1, At, B1); PG8_BAR; PG8_SCHED;
            PG8_LDA(At, 0, 1); PG8_STAGE(PG8_SB(0, 0), b2, voffB); PG8_STAGE(PG8_SB(0, 1), b2 + hstepB, voffB); PG8_STAGE(PG8_SA(0, 0), a2, voffA);
            PG8_WAIT_V(8); PG8_WAIT_L(0); PG8_BAR; PG8_MMA(1, 0, At, B0); PG8_MMA(1, 1, At, B1); PG8_BAR; PG8_SCHED;
            PG8_LDB(B0, 1, 0); PG8_LDB(B1, 1, 1); PG8_SCHED; PG8_LDA(At, 1, 0); PG8_STAGE(PG8_SA(0, 1), a2 + hstepA, voffA);
            PG8_WAIT_V(8); PG8_WAIT_L(0); PG8_BAR; PG8_MMA(0, 0, At, B0); PG8_MMA(0, 1, At, B1); PG8_BAR; PG8_SCHED;
            PG8_LDA(At, 1, 1); PG8_STAGE(PG8_SB(1, 0), b3, voffB); PG8_STAGE(PG8_SB(1, 1), b3 + hstepB, voffB); PG8_STAGE(PG8_SA(1, 0), a3, voffA);
            PG8_WAIT_V(8); PG8_WAIT_L(0); PG8_BAR; PG8_MMA(1, 0, At, B0); PG8_MMA(1, 1, At, B1); PG8_BAR; PG8_SCHED;
        }
        if (wr == 0) PG8_BAR;
        if constexpr (has_pre<Epi>::value) E.pre(acc, cur, wr, wc, lane_id());
        E(acc, cur, wr, wc, lane_id(), lds + EPI_LDS + wid * EPI_WAVE);
        if (!has_next) break;
#pragma unroll
        for (int a = 0; a < 2; ++a)
#pragma unroll
            for (int b = 0; b < 2; ++b)
#pragma unroll
                for (int m = 0; m < 4; ++m)
#pragma unroll
                    for (int n = 0; n < 2; ++n) acc[a][b][m][n] = (f32x4){0.f, 0.f, 0.f, 0.f};
        cur = nxt; cA = nA; cB = nB; ++ui;
        if (wr == 1) PG8_BAR;
    }
    PG8_WAIT_V(0);
    PG8_BAR;
#undef PG8_SA
#undef PG8_SB
#undef PG8_STAGE
#undef PG8_LDA
#undef PG8_LDB
#undef PG8_MMA
#undef PG8_WAIT_V
#undef PG8_WAIT_L
#undef PG8_BAR
#undef PG8_SCHED
}
typedef f32x4 AccT[2][2][4][2];
__device__ __forceinline__ void xp32_w(PG8_LAS unsigned char* xl, int fr, int c, const f32x4& v) { *(PG8_LAS f32x4*)(xl + fr * 128 + (((c ^ fr) & 7) << 4)) = v; }
__device__ __forceinline__ f32x4 xp32_r(const PG8_LAS unsigned char* xl, int r, int c) { return *(const PG8_LAS f32x4*)(xl + r * 128 + (((c ^ r) & 7) << 4)); }
__device__ __forceinline__ void xpw(PG8_LAS unsigned char* xl, int lane, const u32x4& w0, const u32x4& w1, u32x4& o0, u32x4& o1) {
    const int fr = lane & 15, fq = lane >> 4, t8 = lane >> 3, c8 = lane & 7;
    *(PG8_LAS u32x4*)(xl + fr * 128 + (((fq ^ fr) & 7) << 4)) = w0; *(PG8_LAS u32x4*)(xl + fr * 128 + ((((4 + fq) ^ fr) & 7) << 4)) = w1;
    const PG8_LAS unsigned char* rp = xl + t8 * 128 + (((c8 ^ t8) & 7) << 4);
    o0 = *(const PG8_LAS u32x4*)rp; o1 = *(const PG8_LAS u32x4*)(rp + 1024);
}
__device__ __forceinline__ void xpw_rev(PG8_LAS unsigned char* xl, int lane, const u32x4& w0, const u32x4& w1, u32x4& o0, u32x4& o1) {
    const int fr = lane & 15, fq = lane >> 4, t8 = lane >> 3, c8 = lane & 7;
    PG8_LAS unsigned char* wp = xl + t8 * 128 + (((c8 ^ t8) & 7) << 4);
    *(PG8_LAS u32x4*)wp = w0; *(PG8_LAS u32x4*)(wp + 1024) = w1;
    o0 = *(const PG8_LAS u32x4*)(xl + fr * 128 + (((fq ^ fr) & 7) << 4)); o1 = *(const PG8_LAS u32x4*)(xl + fr * 128 + ((((4 + fq) ^ fr) & 7) << 4));
}
__device__ __forceinline__ u32x4 pack8(const f32x4& v0, const f32x4& v1) { u32x4 w; w.x = cvt_pk_bf16(v0[0], v0[1]); w.y = cvt_pk_bf16(v0[2], v0[3]); w.z = cvt_pk_bf16(v1[0], v1[1]); w.w = cvt_pk_bf16(v1[2], v1[3]); return w; }

struct EpiProj { static constexpr bool PERM = true; bf16_t* proj; float* dt;
    __device__ __forceinline__ void operator()(const AccT& acc, const Unit& u, int wr, int wc, int lane, PG8_LAS unsigned char* xl) const {
        if (u.pn * BM >= PJ) {
            const int fr = lane & 15, fq = lane >> 4, row0 = u.pm * BM + wr * 64 + fr;
            if (wc == 0) {
#pragma unroll
                for (int ai = 0; ai < 2; ++ai)
#pragma unroll
                    for (int m = 0; m < 4; ++m) { float* q = dt + (size_t)(row0 + ai * HALF + m * 16) * NDT + 8 * fq; *(f32x4*)q = acc[ai][0][m][0]; *(f32x4*)(q + 4) = acc[ai][0][m][1];
                        if (fq < 2) { *(f32x4*)(q + 32) = acc[ai][1][m][0]; *(f32x4*)(q + 36) = acc[ai][1][m][1]; } }
            }
            return;
        }
        const int t8 = lane >> 3, c8 = lane & 7;
        bf16_t* q0 = proj + (size_t)(u.pm * BM + wr * 64 + t8) * PJ + u.pn * BM + wc * 64 + 8 * c8;
#pragma unroll
        for (int ai = 0; ai < 2; ++ai)
#pragma unroll
            for (int m = 0; m < 4; ++m) { u32x4 o0, o1;
                xpw(xl, lane, pack8(acc[ai][0][m][0], acc[ai][0][m][1]), pack8(acc[ai][1][m][0], acc[ai][1][m][1]), o0, o1);
                bf16_t* q = q0 + (size_t)(ai * HALF + 16 * m) * PJ;
                { bf16_t* q1 = q + (size_t)8 * PJ;
                  ST16_WT(q, o0); ST16_WT(q1, o1); } }
    } };
struct EpiUt { static constexpr bool PERM = true; bf16_t* ut;
    __device__ __forceinline__ void operator()(const AccT& acc, const Unit& u, int wr, int wc, int lane, PG8_LAS unsigned char* xl) const {
        const int t8 = lane >> 3, c8 = lane & 7;
        const int gc0 = u.pm * BM + wr * 64 + t8, tok = u.pn * BM + wc * 64 + 8 * c8;
        bf16_t* qb; int ld;
        if (tok < MLAT) { const int b = tok / SEQ, l = tok % SEQ; qb = ut + (size_t)b * 512 * SEQ + l; ld = SEQ; }
        else { const int t = tok - MLAT, b = t / CTXL, l = t % CTXL; qb = ut + (size_t)NB * 512 * SEQ + (size_t)b * 512 * CTXL + l; ld = CTXL; }
#pragma unroll
        for (int ai = 0; ai < 2; ++ai)
#pragma unroll
            for (int m = 0; m < 4; ++m) { u32x4 o0, o1;
                xpw(xl, lane, pack8(acc[ai][0][m][0], acc[ai][0][m][1]), pack8(acc[ai][1][m][0], acc[ai][1][m][1]), o0, o1);
                const int gc = gc0 + ai * HALF + 16 * m;
                *(u32x4*)(qb + (size_t)gc * ld) = o0; *(u32x4*)(qb + (size_t)(gc + 8) * ld) = o1; }
    } };
struct EpiPQ { static constexpr bool PERM = true; bf16_t* pq; int rowbase, L; float scale;
    __device__ __forceinline__ void operator()(const AccT& acc, const Unit& u, int wr, int wc, int lane, PG8_LAS unsigned char* xl) const {
        const int t8 = lane >> 3, c8 = lane & 7;
        const int row0 = u.pm * BM + wr * 64 + t8, n = u.pn * BM + wc * 64 + 8 * c8, Lh = L >> 1;
        bf16_t* qn = pq + (size_t)(rowbase + (n >> 9) * L) * 1024 + (n & 511);
#pragma unroll
        for (int ai = 0; ai < 2; ++ai)
#pragma unroll
            for (int m = 0; m < 4; ++m) { u32x4 o[2];
                xpw(xl, lane, pack8(acc[ai][0][m][0] * scale, acc[ai][0][m][1] * scale), pack8(acc[ai][1][m][0] * scale, acc[ai][1][m][1] * scale), o[0], o[1]);
#pragma unroll
                for (int s_ = 0; s_ < 2; ++s_) { const int r = row0 + ai * HALF + 16 * m + 8 * s_, part = r >= Lh ? 1 : 0, k = r - part * Lh + 1;
                    bf16_t* q = qn + part * 512;
                    *(u32x4*)(q + (size_t)k * 1024) = o[s_];
                    if (k < Lh) { const unsigned sm = part ? 0x80008000u : 0u; u32x4 w = o[s_]; w.x ^= sm; w.y ^= sm; w.z ^= sm; w.w ^= sm;
                        *(u32x4*)(q + (size_t)(L - k) * 1024) = w; } } }
    } };
struct EpiFl { static constexpr bool PERM = true; bf16_t* proj; const float* bias;
    __device__ __forceinline__ void operator()(const AccT& acc, const Unit& u, int wr, int wc, int lane, PG8_LAS unsigned char* xl) const {
        const int fq = lane >> 4, t8 = lane >> 3, c8 = lane & 7;
        f32x4 bv[2][2];
#pragma unroll
        for (int bj = 0; bj < 2; ++bj)
#pragma unroll
            for (int n = 0; n < 2; ++n) bv[bj][n] = *(const f32x4*)(bias + u.pn * BM + wc * 64 + bj * 32 + 8 * fq + 4 * n);
        bf16_t* q0 = proj + (size_t)(u.pm * BM + wr * 64 + t8) * PJ + PJ_ZF + u.pn * BM + wc * 64 + 8 * c8;
#pragma unroll
        for (int ai = 0; ai < 2; ++ai) {
            u32x4 z[4][2];
#pragma unroll
            for (int m = 0; m < 4; ++m)
#pragma unroll
                for (int s_ = 0; s_ < 2; ++s_) z[m][s_] = *(const u32x4*)(q0 + (size_t)(ai * HALF + m * 16 + 8 * s_) * PJ);
#pragma unroll
            for (int m = 0; m < 4; ++m) { u32x4 zf[2], w[2], o0, o1;
                xpw_rev(xl, lane, z[m][0], z[m][1], zf[0], zf[1]);
#pragma unroll
                for (int bj = 0; bj < 2; ++bj) { const f32x4 v0 = acc[ai][bj][m][0] + bv[bj][0], v1 = acc[ai][bj][m][1] + bv[bj][1]; const u32x4 zz = zf[bj];
                    w[bj].x = cvt_pk_bf16(v0[0] * silu_f(bf2f(zz.x & 0xffffu)), v0[1] * silu_f(bf2f_hi(zz.x))); w[bj].y = cvt_pk_bf16(v0[2] * silu_f(bf2f(zz.y & 0xffffu)), v0[3] * silu_f(bf2f_hi(zz.y)));
                    w[bj].z = cvt_pk_bf16(v1[0] * silu_f(bf2f(zz.z & 0xffffu)), v1[1] * silu_f(bf2f_hi(zz.z))); w[bj].w = cvt_pk_bf16(v1[2] * silu_f(bf2f(zz.w & 0xffffu)), v1[3] * silu_f(bf2f_hi(zz.w))); }
                xpw(xl, lane, w[0], w[1], o0, o1);
                bf16_t* q = q0 + (size_t)(ai * HALF + m * 16) * PJ;
                *(u32x4*)q = o0; *(u32x4*)(q + (size_t)8 * PJ) = o1; }
            asm volatile("" ::: "memory"); }
    } };
struct EpiOut { static constexpr bool PERM = false; const float* xsrc; float* xdst; const float* csrc; float* cdst; const float* mod;
    __device__ __forceinline__ void operator()(const AccT& acc, const Unit& u, int wr, int wc, int lane, PG8_LAS unsigned char* xl) const {
        const int fr = lane & 15, fq = lane >> 4, t8 = lane >> 3, c8 = lane & 7;
        const int row0 = u.pm * BM + wr * 64 + t8, col0 = u.pn * BM + wc * 32 + 4 * c8;
        const bool lat = u.pm < MLAT / BM;
        const float* gp = mod + (lat ? (u.pm >> 3) : 8) * 3072 + 2048 + col0;
        const float* src = lat ? xsrc : csrc - (size_t)MLAT * DM; float* dst = lat ? xdst : cdst - (size_t)MLAT * DM;
        f32x4 gv[2];
#pragma unroll
        for (int bj = 0; bj < 2; ++bj) gv[bj] = *(const f32x4*)(gp + bj * HALF);
#pragma unroll
        for (int ai = 0; ai < 2; ++ai)
#pragma unroll
            for (int mp = 0; mp < 2; ++mp) {
                f32x4 bs[2][2][2];
#pragma unroll
                for (int mm = 0; mm < 2; ++mm)
#pragma unroll
                    for (int bj = 0; bj < 2; ++bj)
#pragma unroll
                        for (int s_ = 0; s_ < 2; ++s_) bs[mm][bj][s_] = *(const f32x4*)(src + (size_t)(row0 + ai * HALF + (2 * mp + mm) * 16 + 8 * s_) * DM + col0 + bj * HALF);
#pragma unroll
                for (int mm = 0; mm < 2; ++mm)
#pragma unroll
                    for (int bj = 0; bj < 2; ++bj) { const int m = 2 * mp + mm;
                        xp32_w(xl, fr, fq, acc[ai][bj][m][0]); xp32_w(xl, fr, 4 + fq, acc[ai][bj][m][1]);
#pragma unroll
                        for (int s_ = 0; s_ < 2; ++s_) { const size_t off = (size_t)(row0 + ai * HALF + m * 16 + 8 * s_) * DM + col0 + bj * HALF;
                            *(f32x4*)(dst + off) = bs[mm][bj][s_] + gv[bj] * xp32_r(xl, 8 * s_ + t8, c8); } }
                asm volatile("" ::: "memory"); }
    } };
struct EpiOutNorm { static constexpr bool PERM = false; const float* xsrc; float* xdst; const float* csrc; float* cdst; const float* mod; const float* nw; const float* nmod; bf16_t* Hn; float* rsq; unsigned* cnt; unsigned target;
    __device__ __forceinline__ void operator()(const AccT& acc, const Unit& u, int wr, int wc, int lane_, PG8_LAS unsigned char* xl) const {
        const int lane = opaque_i(lane_);
        const int fr = lane & 15, fq = lane >> 4, t8 = lane >> 3, c8 = lane & 7, wid = wr * 4 + wc, tid = wid * 64 + lane;
        const int row0 = u.pm * BM + wr * 64 + t8, col0 = u.pn * BM + wc * 32 + 4 * c8;
        PG8_LAS unsigned char* sh = xl - wid * EPI_WAVE;
        const bool lat = u.pm < MLAT / BM; const int mrow = lat ? (u.pm >> 3) : 8;
        const float* gp = mod + mrow * 3072 + 2048 + col0;
        const float* src = lat ? xsrc : csrc - (size_t)MLAT * DM; float* dst = lat ? xdst : cdst - (size_t)MLAT * DM;
        f32x4 gv[2];
#pragma unroll
        for (int bj = 0; bj < 2; ++bj) gv[bj] = *(const f32x4*)(gp + bj * HALF);
        f32x4 xn[2][4][2][2];
        float ssq[2][4][2];
#pragma unroll
        for (int ai = 0; ai < 2; ++ai)
#pragma unroll
            for (int mp = 0; mp < 2; ++mp) {
                f32x4 bs[2][2][2];
#pragma unroll
                for (int mm = 0; mm < 2; ++mm)
#pragma unroll
                    for (int bj = 0; bj < 2; ++bj)
#pragma unroll
                        for (int s_ = 0; s_ < 2; ++s_) bs[mm][bj][s_] = *(const f32x4*)(src + (size_t)(row0 + ai * HALF + (2 * mp + mm) * 16 + 8 * s_) * DM + col0 + bj * HALF);
#pragma unroll
                for (int mm = 0; mm < 2; ++mm) { const int m = 2 * mp + mm;
#pragma unroll
                    for (int bj = 0; bj < 2; ++bj) {
                        xp32_w(xl, fr, fq, acc[ai][bj][m][0]); xp32_w(xl, fr, 4 + fq, acc[ai][bj][m][1]);
#pragma unroll
                        for (int s_ = 0; s_ < 2; ++s_) xn[ai][m][bj][s_] = bs[mm][bj][s_] + gv[bj] * xp32_r(xl, 8 * s_ + t8, c8); }
#pragma unroll
                    for (int s_ = 0; s_ < 2; ++s_) { const f32x4 a = xn[ai][m][0][s_], b = xn[ai][m][1][s_];
                        ssq[ai][m][s_] = a.x * a.x + a.y * a.y + a.z * a.z + a.w * a.w + b.x * b.x + b.y * b.y + b.z * b.z + b.w * b.w; } }
                asm volatile("" ::: "memory"); }
#pragma unroll
        for (int o = 1; o < 8; o <<= 1)
#pragma unroll
            for (int ai = 0; ai < 2; ++ai)
#pragma unroll
                for (int m = 0; m < 4; ++m)
#pragma unroll
                    for (int s_ = 0; s_ < 2; ++s_) ssq[ai][m][s_] += __int_as_float(__builtin_amdgcn_ds_bpermute((lane ^ o) << 2, __float_as_int(ssq[ai][m][s_])));
        asm volatile("s_waitcnt lgkmcnt(0)" ::: "memory"); __builtin_amdgcn_s_barrier();
        if (c8 == 0) {
#pragma unroll
            for (int ai = 0; ai < 2; ++ai)
#pragma unroll
                for (int m = 0; m < 4; ++m)
#pragma unroll
                    for (int s_ = 0; s_ < 2; ++s_) *(PG8_LAS float*)(sh + (wc * 256 + wr * 64 + ai * HALF + m * 16 + 8 * s_ + t8) * 4) = ssq[ai][m][s_]; }
        asm volatile("s_waitcnt lgkmcnt(0)" ::: "memory"); __builtin_amdgcn_s_barrier();
        if (tid < 256) { const float t = *(PG8_LAS float*)(sh + tid * 4) + *(PG8_LAS float*)(sh + (256 + tid) * 4) + *(PG8_LAS float*)(sh + (512 + tid) * 4) + *(PG8_LAS float*)(sh + (768 + tid) * 4);
            __hip_atomic_store(rsq + (size_t)(u.pm * BM + tid) * 4 + u.pn, t, __ATOMIC_RELAXED, __HIP_MEMORY_SCOPE_AGENT); }
        asm volatile("s_waitcnt vmcnt(0)" ::: "memory"); __builtin_amdgcn_s_barrier();
        if (tid == 0) {
            (void)__hip_atomic_fetch_add(cnt + 64 * u.pm, 1u, __ATOMIC_RELAXED, __HIP_MEMORY_SCOPE_AGENT);
            unsigned sp = 0; while (__hip_atomic_load(cnt + 64 * u.pm, __ATOMIC_RELAXED, __HIP_MEMORY_SCOPE_AGENT) < target) { __builtin_amdgcn_s_sleep(2); if (++sp > (1u << 21)) break; } }
        __builtin_amdgcn_s_barrier(); asm volatile("" ::: "memory");
        if (tid < 256) { const float* rp = rsq + (size_t)(u.pm * BM + tid) * 4;
            const float q0 = __hip_atomic_load(rp, __ATOMIC_RELAXED, __HIP_MEMORY_SCOPE_AGENT), q1 = __hip_atomic_load(rp + 1, __ATOMIC_RELAXED, __HIP_MEMORY_SCOPE_AGENT),
                        q2 = __hip_atomic_load(rp + 2, __ATOMIC_RELAXED, __HIP_MEMORY_SCOPE_AGENT), q3 = __hip_atomic_load(rp + 3, __ATOMIC_RELAXED, __HIP_MEMORY_SCOPE_AGENT);
            *(PG8_LAS float*)(sh + 4096 + tid * 4) = rsqrtf(((q0 + q1) + (q2 + q3)) * (1.f / DM) + EPS); }
        asm volatile("s_waitcnt lgkmcnt(0)" ::: "memory"); __builtin_amdgcn_s_barrier();
#pragma unroll
        for (int ai = 0; ai < 2; ++ai)
#pragma unroll
            for (int m = 0; m < 4; ++m)
#pragma unroll
                for (int s_ = 0; s_ < 2; ++s_)
#pragma unroll
                    for (int bj = 0; bj < 2; ++bj) *(f32x4*)(dst + (size_t)(row0 + ai * HALF + m * 16 + 8 * s_) * DM + col0 + bj * HALF) = xn[ai][m][bj][s_];
        const float* sh_ = nmod + mrow * 3072 + col0;
        f32x4 gw[2], s0[2];
#pragma unroll
        for (int bj = 0; bj < 2; ++bj) { const f32x4 w = *(const f32x4*)(nw + col0 + bj * HALF), s1 = *(const f32x4*)(sh_ + 1024 + bj * HALF);
            gw[bj] = (f32x4){w.x * (1.f + s1.x), w.y * (1.f + s1.y), w.z * (1.f + s1.z), w.w * (1.f + s1.w)}; s0[bj] = *(const f32x4*)(sh_ + bj * HALF); }
#pragma unroll
        for (int ai = 0; ai < 2; ++ai)
#pragma unroll
            for (int m = 0; m < 4; ++m)
#pragma unroll
                for (int s_ = 0; s_ < 2; ++s_) { const int rl = wr * 64 + ai * HALF + m * 16 + 8 * s_ + t8; const float ri = *(PG8_LAS float*)(sh + 4096 + rl * 4);
#pragma unroll
                    for (int bj = 0; bj < 2; ++bj) { const f32x4 v = xn[ai][m][bj][s_];
                        u32x2 o; o.x = cvt_pk_bf16(v.x * ri * gw[bj].x + s0[bj].x, v.y * ri * gw[bj].y + s0[bj].y); o.y = cvt_pk_bf16(v.z * ri * gw[bj].z + s0[bj].z, v.w * ri * gw[bj].w + s0[bj].w);
                        *(u32x2*)(Hn + (size_t)(u.pm * BM + rl) * DM + col0 + bj * HALF) = o; } }
    } };
struct EpiPart { static constexpr bool PERM = false; float* part; unsigned* pcnt;
    __device__ __forceinline__ void operator()(const AccT& acc, const Unit& u, int wr, int wc, int lane_, PG8_LAS unsigned char*) const {
        const int lane = opaque_i(lane_), wid = wr * 4 + wc, tid = wid * 64 + lane, unit = (u.pm - MLAT / BM) * 4 + u.pn;
        float* q0 = part + (size_t)(unit * 8 + wid) * 32 * 256 + lane * 4;
#pragma unroll
        for (int ai = 0; ai < 2; ++ai)
#pragma unroll
            for (int bj = 0; bj < 2; ++bj)
#pragma unroll
                for (int m = 0; m < 4; ++m)
#pragma unroll
                    for (int n = 0; n < 2; ++n) { float* q = q0 + (((ai * 2 + bj) * 4 + m) * 2 + n) * 256; ST16_WT(q, acc[ai][bj][m][n]); }
        asm volatile("s_waitcnt vmcnt(0)" ::: "memory"); __builtin_amdgcn_s_barrier();
        if (tid == 0) (void)__hip_atomic_fetch_add(pcnt + 64 * unit, 1u, __ATOMIC_RELAXED, __HIP_MEMORY_SCOPE_AGENT);
    } };
struct EpiOutNormK2 : EpiOutNorm { const float* part; unsigned* pcnt; unsigned ptarget;
    __device__ __forceinline__ void pre(AccT& acc, const Unit& u, int wr, int wc, int lane_) const {
        const int lane = opaque_i(lane_), wid = wr * 4 + wc, tid = wid * 64 + lane, unit = (u.pm - MLAT / BM) * 4 + u.pn;
        if (tid == 0) { unsigned sp = 0; while (__hip_atomic_load(pcnt + 64 * unit, __ATOMIC_RELAXED, __HIP_MEMORY_SCOPE_AGENT) < ptarget) { __builtin_amdgcn_s_sleep(2); if (++sp > (1u << 21)) break; } }
        __builtin_amdgcn_s_barrier(); asm volatile("" ::: "memory");
        const float* q0 = part + (size_t)(unit * 8 + wid) * 32 * 256 + lane * 4;
#pragma unroll
        for (int ai = 0; ai < 2; ++ai)
#pragma unroll
            for (int bj = 0; bj < 2; ++bj)
#pragma unroll
                for (int m = 0; m < 4; m += 2) {
                    const float* q = q0 + (((ai * 2 + bj) * 4 + m) * 2) * 256; f32x4 t0, t1, t2, t3;
                    asm volatile("global_load_dwordx4 %0, %4, off sc1\n\tglobal_load_dwordx4 %1, %4, off offset:1024 sc1\n\tglobal_load_dwordx4 %2, %4, off offset:2048 sc1\n\tglobal_load_dwordx4 %3, %4, off offset:3072 sc1\n\ts_waitcnt vmcnt(0)"
                                 : "=&v"(t0), "=&v"(t1), "=&v"(t2), "=&v"(t3) : "v"(q) : "memory");
                    acc[ai][bj][m][0] += t0; acc[ai][bj][m][1] += t1; acc[ai][bj][m + 1][0] += t2; acc[ai][bj][m + 1][1] += t3; }
    } };
struct EpiOutFin { static constexpr bool PERM = false; const float* xsrc; float* out; const float* mod; const float* fw; float* rsq; unsigned* cnt; unsigned target;
    __device__ __forceinline__ void operator()(const AccT& acc, const Unit& u, int wr, int wc, int lane_, PG8_LAS unsigned char* xl) const {
        const int lane = opaque_i(lane_);
        const int fr = lane & 15, fq = lane >> 4, t8 = lane >> 3, c8 = lane & 7, wid = wr * 4 + wc, tid = wid * 64 + lane;
        const int row0 = u.pm * BM + wr * 64 + t8, col0 = u.pn * BM + wc * 32 + 4 * c8;
        PG8_LAS unsigned char* sh = xl - wid * EPI_WAVE;
        const float* gp = mod + (u.pm >> 3) * 3072 + 2048 + col0;
        f32x4 gv[2];
#pragma unroll
        for (int bj = 0; bj < 2; ++bj) gv[bj] = *(const f32x4*)(gp + bj * HALF);
        f32x4 xn[2][4][2][2];
        float ssq[2][4][2];
#pragma unroll
        for (int ai = 0; ai < 2; ++ai)
#pragma unroll
            for (int mp = 0; mp < 2; ++mp) {
                f32x4 bs[2][2][2];
#pragma unroll
                for (int mm = 0; mm < 2; ++mm)
#pragma unroll
                    for (int bj = 0; bj < 2; ++bj)
#pragma unroll
                        for (int s_ = 0; s_ < 2; ++s_) bs[mm][bj][s_] = *(const f32x4*)(xsrc + (size_t)(row0 + ai * HALF + (2 * mp + mm) * 16 + 8 * s_) * DM + col0 + bj * HALF);
#pragma unroll
                for (int mm = 0; mm < 2; ++mm) { const int m = 2 * mp + mm;
#pragma unroll
                    for (int bj = 0; bj < 2; ++bj) {
                        xp32_w(xl, fr, fq, acc[ai][bj][m][0]); xp32_w(xl, fr, 4 + fq, acc[ai][bj][m][1]);
#pragma unroll
                        for (int s_ = 0; s_ < 2; ++s_) xn[ai][m][bj][s_] = bs[mm][bj][s_] + gv[bj] * xp32_r(xl, 8 * s_ + t8, c8); }
#pragma unroll
                    for (int s_ = 0; s_ < 2; ++s_) { const f32x4 a = xn[ai][m][0][s_], b = xn[ai][m][1][s_];
                        ssq[ai][m][s_] = a.x * a.x + a.y * a.y + a.z * a.z + a.w * a.w + b.x * b.x + b.y * b.y + b.z * b.z + b.w * b.w; } }
                asm volatile("" ::: "memory"); }
#pragma unroll
        for (int o = 1; o < 8; o <<= 1)
#pragma unroll
            for (int ai = 0; ai < 2; ++ai)
#pragma unroll
                for (int m = 0; m < 4; ++m)
#pragma unroll
                    for (int s_ = 0; s_ < 2; ++s_) ssq[ai][m][s_] += __int_as_float(__builtin_amdgcn_ds_bpermute((lane ^ o) << 2, __float_as_int(ssq[ai][m][s_])));
        asm volatile("s_waitcnt lgkmcnt(0)" ::: "memory"); __builtin_amdgcn_s_barrier();
        if (c8 == 0) {
#pragma unroll
            for (int ai = 0; ai < 2; ++ai)
#pragma unroll
                for (int m = 0; m < 4; ++m)
#pragma unroll
                    for (int s_ = 0; s_ < 2; ++s_) *(PG8_LAS float*)(sh + (wc * 256 + wr * 64 + ai * HALF + m * 16 + 8 * s_ + t8) * 4) = ssq[ai][m][s_]; }
        asm volatile("s_waitcnt lgkmcnt(0)" ::: "memory"); __builtin_amdgcn_s_barrier();
        if (tid < 256) { const float t = *(PG8_LAS float*)(sh + tid * 4) + *(PG8_LAS float*)(sh + (256 + tid) * 4) + *(PG8_LAS float*)(sh + (512 + tid) * 4) + *(PG8_LAS float*)(sh + (768 + tid) * 4);
            __hip_atomic_store(rsq + (size_t)(u.pm * BM + tid) * 4 + u.pn, t, __ATOMIC_RELAXED, __HIP_MEMORY_SCOPE_AGENT); }
        asm volatile("s_waitcnt vmcnt(0)" ::: "memory"); __builtin_amdgcn_s_barrier();
        if (tid == 0) {
            (void)__hip_atomic_fetch_add(cnt + 64 * u.pm, 1u, __ATOMIC_RELAXED, __HIP_MEMORY_SCOPE_AGENT);
            unsigned sp = 0; while (__hip_atomic_load(cnt + 64 * u.pm, __ATOMIC_RELAXED, __HIP_MEMORY_SCOPE_AGENT) < target) { __builtin_amdgcn_s_sleep(2); if (++sp > (1u << 21)) break; } }
        __builtin_amdgcn_s_barrier(); asm volatile("" ::: "memory");
        if (tid < 256) { const float* rp = rsq + (size_t)(u.pm * BM + tid) * 4;
            const float q0 = __hip_atomic_load(rp, __ATOMIC_RELAXED, __HIP_MEMORY_SCOPE_AGENT), q1 = __hip_atomic_load(rp + 1, __ATOMIC_RELAXED, __HIP_MEMORY_SCOPE_AGENT),
                        q2 = __hip_atomic_load(rp + 2, __ATOMIC_RELAXED, __HIP_MEMORY_SCOPE_AGENT), q3 = __hip_atomic_load(rp + 3, __ATOMIC_RELAXED, __HIP_MEMORY_SCOPE_AGENT);
            *(PG8_LAS float*)(sh + 4096 + tid * 4) = rsqrtf(((q0 + q1) + (q2 + q3)) * (1.f / DM) + EPS); }
        asm volatile("s_waitcnt lgkmcnt(0)" ::: "memory"); __builtin_amdgcn_s_barrier();
        f32x4 wv[2];
#pragma unroll
        for (int bj = 0; bj < 2; ++bj) wv[bj] = *(const f32x4*)(fw + col0 + bj * HALF);
#pragma unroll
        for (int ai = 0; ai < 2; ++ai)
#pragma unroll
            for (int m = 0; m < 4; ++m)
#pragma unroll
                for (int s_ = 0; s_ < 2; ++s_) { const int rl = wr * 64 + ai * HALF + m * 16 + 8 * s_ + t8; const float ri = *(PG8_LAS float*)(sh + 4096 + rl * 4);
#pragma unroll
                    for (int bj = 0; bj < 2; ++bj) { const f32x4 v = xn[ai][m][bj][s_];
                        *(f32x4*)(out + (size_t)(u.pm * BM + rl) * DM + col0 + bj * HALF) = (f32x4){v.x * ri * wv[bj].x, v.y * ri * wv[bj].y, v.z * ri * wv[bj].z, v.w * ri * wv[bj].w}; } }
    } };
}
template <class Epi>
__device__ __forceinline__ int fgemm_all_(int wv, unsigned char* smem, const bf16_t* A, int lda, const bf16_t* Bt, int ldb, int M, int N, int K, const Epi& epi, int first, int bid, int G, int row0 = 0) {
    if (bid < 0) return (M / 256) * (N / 256);
    pg8::StaticOrder S; S.init(M, N, G, (bid - first % G + G) % G, row0 / 256);
    pg8::gemm_phase<Epi>((PG8_LAS unsigned char*)smem, pg8::Gemm{A, Bt, lda, ldb, K}, S, epi, wv);
    return S.nwg;
}

__device__ __forceinline__ void ph_conv(const Params& p, unsigned char* smem, int layer, int it0, int it1, int bid, int G) {
    bf16_t* proj = (bf16_t*)(p.ws + WS_PROJ);
    const float* cw = p.conv_w + (size_t)layer * 9 * CONVCH; const float* cb = p.conv_b + (size_t)layer * CONVCH;
    const int tid = TIDX;
    constexpr int NCB = CONVCH / 32;
    if (bid < 0) return;
    const int cq = tid & 7, tl = tid >> 3;
    u32x4 pre[16];
#define CONV_CBLK(r_) ({ const int r__ = (r_), c__ = 8 * (r__ >> 4) + (r__ & 7); 2 * c__ + ((r__ >> 3) & 1); })
#define CONV_ISSUE(it_) do { const bf16_t* b_ = proj + (size_t)((it_) / NCB * SEQ) * PJ + PJ_XS + CONV_CBLK((it_) % NCB) * 32; \
        _Pragma("unroll") for (int q = 0; q < 16; ++q) { const int e = tid + NT * q; pre[q] = *(const u32x4*)(b_ + (size_t)(e >> 2) * PJ + (e & 3) * 8); } } while (0)
    const int lat_end = it1 < 8 * NCB ? it1 : 8 * NCB;
    constexpr int CW = GRIDW + 2, CH_ = SEQ / GRIDW + 2;
    if (it0 + bid < lat_end) {
        for (int s = tid; s < CH_ * CW; s += NT) { const int rr = s / CW, cc = s % CW;
            if (rr == 0 || rr == CH_ - 1 || cc == 0 || cc == CW - 1) { const unsigned z_ = (unsigned)opaque_i(0); const u32x4 zv = (u32x4){z_, z_, z_, z_};
                *(u32x4*)(smem + s * 64) = zv; *(u32x4*)(smem + s * 64 + 16) = zv; *(u32x4*)(smem + s * 64 + 32) = zv; *(u32x4*)(smem + s * 64 + 48) = zv; } }
    }
    const bool bal = (G == 256 && it0 == 0 && it1 == 16 * NCB);
#define CONV_NEXT(it_) (!bal ? (it_) + G : (it_) >= 8 * NCB ? (it_) + 128 : (it_) + 256 < 8 * NCB ? (it_) + 256 : bid >= 128 ? 8 * NCB + bid - 128 : it1)
    int it = it0 + bid;
    if (it < lat_end) CONV_ISSUE(it);
    for (; it < it1; it = CONV_NEXT(it)) {
        const int sq = it / NCB, cblk = CONV_CBLK(it % NCB);
        int L, rows, cols, row0;
        if (sq < 8) { L = SEQ; rows = SEQ / GRIDW; cols = GRIDW; row0 = sq * SEQ; } else { L = CTXL; rows = 1; cols = CTXL; row0 = MLAT + (sq - 8) * CTXL; }
        bf16_t* base = proj + (size_t)row0 * PJ + PJ_XS + cblk * 32;
        if (sq < 8) {
#pragma unroll
            for (int q = 0; q < 16; ++q) { const int e = tid + NT * q, t = e >> 2; *(u32x4*)(smem + (((t >> 6) + 1) * CW + 1 + (t & 63)) * 64 + (e & 3) * 16) = pre[q]; }
        } else {
            for (int e = tid; e < L * 4; e += NT) { const int t = e >> 2, q = e & 3; *(u32x4*)(smem + t * 64 + q * 16) = *(const u32x4*)(base + (size_t)t * PJ + q * 8); }
        }
        __syncthreads();
        { const int nx_ = CONV_NEXT(it); if (nx_ < lat_end) CONV_ISSUE(nx_); }
        const int ch = cblk * 32 + cq * 4;
        float w[9][4], bias[4];
#pragma unroll
        for (int k = 0; k < 9; ++k)
#pragma unroll
            for (int j = 0; j < 4; ++j) w[k][j] = cw[k * CONVCH + ch + j];
#pragma unroll
        for (int j = 0; j < 4; ++j) bias[j] = cb[ch + j];
        if (sq < 8) {
            const int c = tl;
            const unsigned char* colp = smem + (size_t)c * 64 + cq * 8;
            float W0[3][4], W1[3][4], W2[3][4];
#define CONV_LD(dst_, R_) do { const unsigned char* rp_ = colp + (size_t)(R_) * (CW * 64); const u32x2 v0_ = *(const u32x2*)rp_, v1_ = *(const u32x2*)(rp_ + 64), v2_ = *(const u32x2*)(rp_ + 128); \
                dst_[0][0] = bf2f(v0_.x & 0xffffu); dst_[0][1] = bf2f_hi(v0_.x); dst_[0][2] = bf2f(v0_.y & 0xffffu); dst_[0][3] = bf2f_hi(v0_.y); \
                dst_[1][0] = bf2f(v1_.x & 0xffffu); dst_[1][1] = bf2f_hi(v1_.x); dst_[1][2] = bf2f(v1_.y & 0xffffu); dst_[1][3] = bf2f_hi(v1_.y); \
                dst_[2][0] = bf2f(v2_.x & 0xffffu); dst_[2][1] = bf2f_hi(v2_.x); dst_[2][2] = bf2f(v2_.y & 0xffffu); dst_[2][3] = bf2f_hi(v2_.y); } while (0)
#define CONV_ROW(o_, r_, T_, M_, B_) do { CONV_LD(B_, (r_) + 2); float a_[4] = {bias[0], bias[1], bias[2], bias[3]}; \
                _Pragma("unroll") for (int j = 0; j < 3; ++j) _Pragma("unroll") for (int e = 0; e < 4; ++e) a_[e] = __builtin_fmaf(w[6 + j][e], B_[j][e], __builtin_fmaf(w[3 + j][e], M_[j][e], __builtin_fmaf(w[j][e], T_[j][e], a_[e])));   \
                o_.x = pk2(silu_f(a_[0]), silu_f(a_[1])); o_.y = pk2(silu_f(a_[2]), silu_f(a_[3])); } while (0)
#define CONV_PAIR(r_, A0_, A1_, A2_) do { u32x2 oa_, ob_; CONV_ROW(oa_, (r_), A0_, A1_, A2_); CONV_ROW(ob_, (r_) + 1, A1_, A2_, A0_); \
                const unsigned sx_ = odd ? oa_.x : ob_.x, sy_ = odd ? oa_.y : ob_.y; \
                const unsigned rx_ = (unsigned)__builtin_amdgcn_update_dpp(0, (int)sx_, 0xB1, 0xf, 0xf, false), ry_ = (unsigned)__builtin_amdgcn_update_dpp(0, (int)sy_, 0xB1, 0xf, 0xf, false); \
                u32x4 o4_; o4_.x = odd ? rx_ : oa_.x; o4_.y = odd ? ry_ : oa_.y; o4_.z = odd ? ob_.x : rx_; o4_.w = odd ? ob_.y : ry_; \
                *(u32x4*)(base + (size_t)(((r_) + odd) * GRIDW + c) * PJ + (cq & 6) * 4) = o4_; } while (0)
            const int odd = cq & 1;
            CONV_LD(W0, 0); CONV_LD(W1, 1);
            for (int r = 0; r < SEQ / GRIDW - 2; r += 6) {
                CONV_PAIR(r, W0, W1, W2);
                CONV_PAIR(r + 2, W2, W0, W1);
                CONV_PAIR(r + 4, W1, W2, W0);
            }
            CONV_PAIR(SEQ / GRIDW - 2, W0, W1, W2);
#undef CONV_LD
#undef CONV_ROW
#undef CONV_PAIR
        } else {
            for (int t = tl; t < CTXL; t += 64) {
                float a[4] = {bias[0], bias[1], bias[2], bias[3]};
#pragma unroll
                for (int j = 0; j < 3; ++j) { const int c2 = t + j - 1; if (c2 < 0 || c2 >= CTXL) continue;
                    const u32x2 v = *(const u32x2*)(smem + c2 * 64 + cq * 8);
                    a[0] += w[3 + j][0] * bf2f(v.x & 0xffffu); a[1] += w[3 + j][1] * bf2f_hi(v.x); a[2] += w[3 + j][2] * bf2f(v.y & 0xffffu); a[3] += w[3 + j][3] * bf2f_hi(v.y); }
                u32x2 o; o.x = pk2(silu_f(a[0]), silu_f(a[1])); o.y = pk2(silu_f(a[2]), silu_f(a[3]));
                *(u32x2*)(base + (size_t)t * PJ + cq * 4) = o;
            }
        }
        __syncthreads();
    }
#undef CONV_NEXT
#undef CONV_ISSUE
#undef CONV_CBLK
}

constexpr int CW_IDLE = 8192, CW_CTXDONE = 8256;
__device__ __forceinline__ void cnt_signal(unsigned* cnt, int wv) {
    asm volatile("s_waitcnt vmcnt(0)" ::: "memory");
    __syncthreads();
    if (wv == 0 && lane_id() == 0) { __builtin_amdgcn_fence(__ATOMIC_RELEASE, "agent"); asm volatile("s_waitcnt vmcnt(0)" ::: "memory"); (void)__hip_atomic_fetch_add(cnt, 1u, __ATOMIC_RELAXED, __HIP_MEMORY_SCOPE_AGENT); }
}
__device__ __forceinline__ void cnt_signal_wt(unsigned* cnt, int wv) {
    asm volatile("s_waitcnt vmcnt(0)" ::: "memory");
    __syncthreads();
    if (wv == 0 && lane_id() == 0) (void)__hip_atomic_fetch_add(cnt, 1u, __ATOMIC_RELAXED, __HIP_MEMORY_SCOPE_AGENT);
}
__device__ __forceinline__ void cnt_wait(unsigned* cnt, unsigned target, int wv) {
    if (wv == 0 && lane_id() == 0) {
        unsigned sp = 0; while (__hip_atomic_load(cnt, __ATOMIC_RELAXED, __HIP_MEMORY_SCOPE_AGENT) < target) { __builtin_amdgcn_s_sleep(2); if (++sp > (1u << 21)) break; }
    }
    __syncthreads();
    __builtin_amdgcn_fence(__ATOMIC_ACQUIRE, "agent"); asm volatile("s_waitcnt vmcnt(0)" ::: "memory");
}

namespace ssd {
#define LAS __attribute__((address_space(3)))
typedef float f32x16 __attribute__((ext_vector_type(16)));
typedef float f32x8 __attribute__((ext_vector_type(8)));
typedef short s16x4 __attribute__((ext_vector_type(4)));
typedef __bf16 bf16v8 __attribute__((ext_vector_type(8)));
constexpr int OFF_BH = 0, OFF_XH = 16384, OFF_SIMG = 32768, OFF_TAB = 49152, TABSZ = 3072, OFF_YST = 49152 + 2 * TABSZ, TEAM_BYTES = OFF_YST + 16384;
constexpr int T_ACUM = 0, T_DT = 512, T_RF = 1024, T_W = 1536, T_EAC = 2048, T_E = 2560;
constexpr int NCHUNK = (CTXL + SEQ) / 128;
__device__ __forceinline__ unsigned off_b(unsigned row, unsigned ch) { return 256u * row + 16u * (ch ^ (((row & 3) << 2) | ((row >> 2) & 3))); }
__device__ __forceinline__ int crow(int r, int h) { return (r & 3) + 8 * (r >> 2) + 4 * h; }
#define MFMA32(a, b, c) __builtin_amdgcn_mfma_f32_32x32x16_bf16((a), (b), (c), 0, 0, 0)
__device__ __forceinline__ LAS unsigned char* las_ptr(unsigned a) { return (LAS unsigned char*)(size_t)a; }
__device__ __forceinline__ unsigned las_int(LAS unsigned char* p) { return (unsigned)(size_t)p; }
__device__ __forceinline__ bf16x8 trpair(LAS unsigned char* p0, LAS unsigned char* p1) {
    const s16x4 lo = __builtin_amdgcn_ds_read_tr16_b64_v4i16((LAS s16x4*)p0), hi = __builtin_amdgcn_ds_read_tr16_b64_v4i16((LAS s16x4*)p1);
    return __builtin_shufflevector(lo, hi, 0, 1, 2, 3, 4, 5, 6, 7);
}

__device__ __forceinline__ void ph_ssd(const Params& p, unsigned char* smem_, int layer, int bid, int G) {
    const int tid = TIDX, lane0 = tid & 63, wave = __builtin_amdgcn_readfirstlane(tid >> 6), d = wave >> 2, wi = wave & 3;
    const int i = d ? 3 - wi : wi, nb = wi;
    int lane = lane0, tt = tid & 255, h = lane >> 5, l31 = lane & 31;
    LAS unsigned char* lb = (LAS unsigned char*)smem_ + d * TEAM_BYTES;
    LAS unsigned char* BH = lb + OFF_BH; LAS unsigned char* XH = lb + OFF_XH; LAS unsigned char* SIMG = lb + OFF_SIMG;
    LAS unsigned char* YST = lb + OFF_YST;
    const bool tabwave = (i == 0);
    bf16_t* proj = (bf16_t*)(p.ws + WS_PROJ); const float* dtb = (const float*)(p.ws + WS_DT); bf16_t* stash = (bf16_t*)(p.ws + WS_STASH);
    unsigned tq = (lane & 15) >> 2, tp = lane & 3, tblk = (lane >> 4) & 1;
    for (int it = bid; it < NB * NH; it += G) {
        const int b = it % NB, head = it / NB, g = head / HPG;
        const float Aneg = -__expf(p.a_log[(layer * 2 + d) * NH + head]), dbias = p.dt_bias[(layer * 2 + d) * NH + head];
        const float dskip = d ? 0.f : p.d_skip[layer * NH + head];
        f32x16 st[2];
#pragma unroll
        for (int r = 0; r < 16; ++r) { st[0][r] = 0.f; st[1][r] = 0.f; }
#pragma unroll
        for (int q = 0; q < 4; ++q) { const unsigned z_ = (unsigned)opaque_i(0); *(LAS u32x4*)(SIMG + (tt + 256 * q) * 16) = (u32x4){z_, z_, z_, z_}; }
#define SSD_BASE(k_) ({ const int c_ = d ? ((k_) < 2 ? 1 - (k_) : NCHUNK + 1 - (k_)) : (k_); c_ < 2 ? MLAT + b * CTXL + 128 * c_ : b * SEQ + 128 * (c_ - 2); })
#define SSD_ROW(base_, t_) ((base_) + (d ? 127 - (t_) : (t_)))
#define SSD_TL(t_) ((unsigned)(d ? 127 - (t_) : (t_)))
#define SSD_PB(base_) ((const char*)proj + (size_t)(base_) * (PJ * 2))
#define SSD_SB(base_) ((char*)stash + (size_t)(base_) * (DSSD * 2))
#define SSD_LD_B(base_, half_, br_) do { _Pragma("unroll") for (int q = 0; q < 4; ++q) { const int t_ = 64 * (half_) + (tt >> 4) + 16 * q; \
            br_[q] = *(const u32x4*)(SSD_PB(base_) + (__umul24(SSD_TL(t_), (unsigned)(PJ * 2)) + (unsigned)((PJ_B + g * DSTATE + (tt & 15) * 8) * 2))); } } while (0)
#define SSD_ST_B(br_) do { LAS unsigned char* sb_ = BH + off_b(tt >> 4, tt & 15);        \
            _Pragma("unroll") for (int q = 0; q < 4; ++q) *(LAS u32x4*)(sb_ + q * 4096) = br_[q]; } while (0)
#define SSD_LD_X(base_, half_, xr_) do { _Pragma("unroll") for (int q = 0; q < 2; ++q) { const int t_ = 64 * (half_) + (tt >> 3) + 32 * q; \
            xr_[q] = *(const u32x4*)(SSD_PB(base_) + (__umul24(SSD_TL(t_), (unsigned)(PJ * 2)) + (unsigned)((PJ_XS + head * HD + (tt & 7) * 8) * 2))); } } while (0)
#define SSD_ST_X(xr_) do { _Pragma("unroll") for (int q = 0; q < 2; ++q) *(LAS u32x4*)(XH + q * 8192 + off_b(tt >> 3, tt & 7)) = xr_[q]; } while (0)
#define SSD_ST_XW(half_, xr_) do { _Pragma("unroll") for (int q = 0; q < 2; ++q) { const float w_ = *(LAS float*)(TAB + T_W + (64 * (half_) + 32 * q + (tt >> 3)) * 4); const u32x4 v_ = xr_[q]; u32x4 o_; \
            o_.x = pk2(fmul1(bf2f(v_.x & 0xffffu), w_), fmul1(bf2f_hi(v_.x), w_)); o_.y = pk2(fmul1(bf2f(v_.y & 0xffffu), w_), fmul1(bf2f_hi(v_.y), w_)); \
            o_.z = pk2(fmul1(bf2f(v_.z & 0xffffu), w_), fmul1(bf2f_hi(v_.z), w_)); o_.w = pk2(fmul1(bf2f(v_.w & 0xffffu), w_), fmul1(bf2f_hi(v_.w), w_)); \
            *(LAS u32x4*)(XH + q * 8192 + off_b(tt >> 3, 8 + (tt & 7))) = o_; } } while (0)
#define SSD_LD_C(base_, cf_) do { const bf16_t* cp_ = (const bf16_t*)(SSD_PB(base_) + (__umul24(SSD_TL(32 * i + l31), (unsigned)(PJ * 2)) + (unsigned)((PJ_C + g * DSTATE + 8 * h) * 2))); \
            _Pragma("unroll") for (int s_ = 0; s_ < 8; ++s_) cf_[s_] = *(const bf16x8*)(cp_ + 16 * s_); } while (0)
#define SSD_TABLES(T, d0_, d1_) do { \
            const float dt0 = softplus_f(d0_ + dbias), dt1 = softplus_f(d1_ + dbias); float v0 = dt0 * Aneg, v1 = dt1 * Aneg; \
            _Pragma("unroll") for (int o = 1; o < 64; o <<= 1) { const float t0 = shup(v0, o, lane), t1 = shup(v1, o, lane); if (lane >= o) { v0 += t0; v1 += t1; } } \
            const float tot0 = rdl(v0, 63); v1 += tot0; const float E0 = rdl(v0, 31), E2 = rdl(v1, 31), E3 = rdl(v1, 63); \
            const float eb0 = lane < 32 ? E0 : tot0, eb1 = lane < 32 ? E2 : E3; \
            T[T_ACUM / 4 + lane] = v0; T[T_ACUM / 4 + 64 + lane] = v1; T[T_DT / 4 + lane] = dt0; T[T_DT / 4 + 64 + lane] = dt1; \
            T[T_RF / 4 + lane] = dt0 * __expf(eb0 - v0); T[T_RF / 4 + 64 + lane] = dt1 * __expf(eb1 - v1); \
            T[T_W / 4 + lane] = dt0 * __expf(E3 - v0); T[T_W / 4 + 64 + lane] = dt1 * __expf(E3 - v1); \
            T[T_EAC / 4 + lane] = __expf(v0); T[T_EAC / 4 + 64 + lane] = __expf(v1); \
            if (lane == 0) { T[T_E / 4 + 0] = E0; T[T_E / 4 + 1] = tot0; T[T_E / 4 + 2] = E2; T[T_E / 4 + 3] = E3; } } while (0)
#define SSD_LD_DT(base_, d0_, d1_) do { if (tabwave) { const char* db_ = (const char*)dtb + (size_t)(base_) * (NDT * 4) + (d * NH + head) * 4; d0_ = *(const float*)(db_ + __umul24(SSD_TL(lane), (unsigned)(NDT * 4))); d1_ = *(const float*)(db_ + __umul24(SSD_TL(lane + 64), (unsigned)(NDT * 4))); } } while (0)
        int base = SSD_BASE(0);
        u32x4 br[4], xr[2]; bf16x8 cf[8]; float dr0 = 0.f, dr1 = 0.f;
        { float d00 = 0.f, d01 = 0.f; SSD_LD_DT(base, d00, d01); SSD_LD_B(base, 0, br); SSD_LD_X(base, 0, xr); SSD_LD_C(base, cf);
          { const int b1_ = SSD_BASE(1); SSD_LD_DT(b1_, dr0, dr1); }
          if (tabwave) { LAS float* T0 = (LAS float*)(lb + OFF_TAB); SSD_TABLES(T0, d00, d01); } }
        __syncthreads();
        for (int k = 0; k < NCHUNK; ++k) {
#define SSD_RELANE() do { lane = opaque_i(lane0); tt = wi * 64 + lane; h = lane >> 5; l31 = lane & 31; tq = (lane & 15) >> 2; tp = lane & 3; tblk = (lane >> 4) & 1; } while (0)
            SSD_RELANE();
            const int nbase = (k + 1 < NCHUNK) ? SSD_BASE(k + 1) : base;
            LAS unsigned char* TAB = lb + OFF_TAB + (k & 1) * TABSZ;
            const int n2base = (k + 2 < NCHUNK) ? SSD_BASE(k + 2) : nbase;
            SSD_ST_B(br); SSD_ST_X(xr);
            SSD_ST_XW(0, xr);
            SSD_LD_B(base, 1, br); SSD_LD_X(base, 1, xr);
            const unsigned lbase = las_int(lb);
            unsigned LBt = lbase + off_b(l31, h);
            f32x16 ya[2];
#pragma unroll
            for (int r = 0; r < 16; ++r) { ya[0][r] = 0.f; ya[1][r] = 0.f; }
#pragma unroll
            for (int s_ = 0; s_ < 8; ++s_)
#pragma unroll
                for (int pt = 0; pt < 2; ++pt) { const bf16x8 sb = *(const LAS bf16x8*)las_ptr((LBt ^ (unsigned)(s_ << 5)) + OFF_SIMG + pt * 8192); ya[pt] = MFMA32(cf[s_], sb, ya[pt]); }
            {
                const float eend = __expf(*(LAS float*)(TAB + T_E + 12));
#pragma unroll
                for (int q = 0; q < 4; ++q) { const f32x4 ea = *(LAS f32x4*)(TAB + T_EAC + (32 * i + 8 * q + 4 * h) * 4);
#pragma unroll
                    for (int e = 0; e < 4; ++e) { ya[0][4 * q + e] = fmul1(ya[0][4 * q + e], ea[e]); ya[1][4 * q + e] = fmul1(ya[1][4 * q + e], ea[e]); } }
#pragma unroll
                for (int r = 0; r < 16; ++r) { st[0][r] = fmul1(st[0][r], eend); st[1][r] = fmul1(st[1][r], eend); }
            }
            const float al = *(LAS float*)(TAB + T_ACUM + (32 * i + l31) * 4);
            __syncthreads();

#define SSD_TILE_BASES() do { const unsigned c2_ = 2u * tblk + (tp >> 1), o8_ = 8u * (tp & 1); LBt = lbase + off_b(l31, h); \
                GXt = lbase + off_b(4 * h + tq, c2_) + o8_; const unsigned ub_ = lbase + off_b(8 * h + tq, c2_) + o8_; UBt = ub_ ^ (64u * (unsigned)nb); XWt = ub_ ^ 128u; } while (0)
            unsigned GXt, UBt, XWt;
            SSD_TILE_BASES();
#pragma unroll
            for (int hh = 0; hh < 2; ++hh) {
                if (hh == 1) {
                    __syncthreads();
                    SSD_ST_B(br); SSD_ST_X(xr); SSD_ST_XW(1, xr);
                    SSD_LD_B(nbase, 0, br); SSD_LD_X(nbase, 0, xr);
                    __syncthreads();
                    SSD_RELANE();
                    SSD_TILE_BASES();
                    if (tabwave) { LAS float* Tn = (LAS float*)(lb + OFF_TAB + ((k + 1) & 1) * TABSZ); SSD_TABLES(Tn, dr0, dr1); }
                    SSD_LD_DT(n2base, dr0, dr1);
                }
#pragma unroll
                for (int jj = 0; jj < 2; ++jj) {
                    const int j = 2 * hh + jj;
                    LAS unsigned char* bt = BH + jj * 8192; LAS unsigned char* xt = XH + jj * 8192;
                    if (j <= i) {
                        f32x16 cb;
#pragma unroll
                        for (int r = 0; r < 16; ++r) cb[r] = 0.f;
#pragma unroll
                        for (int s_ = 0; s_ < 8; ++s_) { const bf16x8 ba = *(const LAS bf16x8*)las_ptr((LBt ^ (unsigned)(s_ << 5)) + OFF_BH + jj * 8192); cb = MFMA32(ba, cf[s_], cb); }
                        bf16x8 xb0[2];
#pragma unroll
                        for (int pt = 0; pt < 2; ++pt)
                            xb0[pt] = trpair(las_ptr((GXt ^ (unsigned)(64 * pt)) + OFF_XH + jj * 8192), las_ptr((GXt ^ (unsigned)(64 * pt) ^ 32u) + 2048 + OFF_XH + jj * 8192));
                        if (j < i) {
                            const float fl = __expf(al - *(LAS float*)(TAB + T_E + j * 4));
#pragma unroll
                            for (int q = 0; q < 4; ++q) { const f32x4 rf = *(LAS f32x4*)(TAB + T_RF + (32 * j + 8 * q + 4 * h) * 4);
#pragma unroll
                                for (int e = 0; e < 4; ++e) cb[4 * q + e] = fmul1(cb[4 * q + e], fmul1(rf[e], fl)); }
                        } else {
#pragma unroll
                            for (int q = 0; q < 4; ++q) { const f32x4 as = *(LAS f32x4*)(TAB + T_ACUM + (32 * j + 8 * q + 4 * h) * 4), ds = *(LAS f32x4*)(TAB + T_DT + (32 * j + 8 * q + 4 * h) * 4);
#pragma unroll
                                for (int e = 0; e < 4; ++e) { const int sl = 8 * q + 4 * h + e; const float v = fmul1(fmul1(cb[4 * q + e], ds[e]), __expf(al - as[e]));
                                    cb[4 * q + e] = sl <= l31 ? v : 0.f; } }
                            if (d == 0) {
#pragma unroll
                                for (int q = 0; q < 4; ++q)
#pragma unroll
                                    for (int e = 0; e < 4; ++e) cb[4 * q + e] += (8 * q + 4 * h + e == l31) ? dskip : 0.f; }
                        }
#pragma unroll
                        for (int ks = 0; ks < 2; ++ks) {
                            f32x8 gv;
#pragma unroll
                            for (int e = 0; e < 8; ++e) gv[e] = cb[8 * ks + e];
                            const bf16x8 ga = __builtin_bit_cast(bf16x8, __builtin_convertvector(gv, bf16v8));
#pragma unroll
                            for (int pt = 0; pt < 2; ++pt) {
                                const bf16x8 xb = ks == 0 ? xb0[pt] : trpair(las_ptr((GXt ^ (unsigned)(64 * pt)) + 4096 + OFF_XH + jj * 8192), las_ptr((GXt ^ (unsigned)(64 * pt) ^ 32u) + 4096 + 2048 + OFF_XH + jj * 8192));
                                ya[pt] = MFMA32(ga, xb, ya[pt]); }
                        }
                    }
#pragma unroll
                    for (int ks = 0; ks < 2; ++ks) {
                        const bf16x8 ab = trpair(las_ptr(UBt + 4096 * ks + OFF_BH + jj * 8192), las_ptr((UBt ^ 16u) + 1024 + 4096 * ks + OFF_BH + jj * 8192));
#pragma unroll
                        for (int pt = 0; pt < 2; ++pt) {
                            const bf16x8 xw = trpair(las_ptr((XWt ^ (unsigned)(64 * pt)) + 4096 * ks + OFF_XH + jj * 8192), las_ptr((XWt ^ (unsigned)(64 * pt) ^ 16u) + 1024 + 4096 * ks + OFF_XH + jj * 8192));
                            st[pt] = MFMA32(ab, xw, st[pt]); }
                    }
                }
            }
            const int rbase = base;
            base = nbase; SSD_LD_C(base, cf);

            const bool first_vis = (k == 0 || (k >= 2 && k <= 9));
#define SSD_PHASE_F() do { const unsigned FBt = lbase + off_b(l31, 4 * nb) + 8 * h; \
                _Pragma("unroll") for (int pt = 0; pt < 2; ++pt) _Pragma("unroll") for (int q = 0; q < 4; ++q) { u32x2 o; o.x = pk2(st[pt][4 * q], st[pt][4 * q + 1]); o.y = pk2(st[pt][4 * q + 2], st[pt][4 * q + 3]); \
                    *(LAS u32x2*)las_ptr((FBt ^ (unsigned)(16 * q)) + OFF_SIMG + pt * 8192) = o; } \
                _Pragma("unroll") for (int pt = 0; pt < 2; ++pt) _Pragma("unroll") for (int r2 = 0; r2 < 8; ++r2) { const unsigned v = pk2(ya[pt][2 * r2], ya[pt][2 * r2 + 1]);        \
                    *(LAS bf16_t*)(YST + ((32 * i + crow(2 * r2, h)) * 64 + 32 * pt + l31) * 2) = (bf16_t)(v & 0xffffu); \
                    *(LAS bf16_t*)(YST + ((32 * i + crow(2 * r2 + 1, h)) * 64 + 32 * pt + l31) * 2) = (bf16_t)(v >> 16); } \
                __syncthreads(); } while (0)
            if (first_vis) {
                SSD_PHASE_F();
#pragma unroll
                for (int q = 0; q < 4; ++q) { const int e = tt + 256 * q, l = e >> 3, ch = e & 7;
                    *(u32x4*)(SSD_SB(rbase) + (__umul24(SSD_TL(l), (unsigned)(DSSD * 2)) + (unsigned)((head * HD + ch * 8) * 2))) = *(LAS u32x4*)(YST + l * 128 + ch * 16); }
            } else {
                u32x4 sv[4];
#pragma unroll
                for (int q = 0; q < 4; ++q) { const int e = tt + 256 * q, l = e >> 3, ch = e & 7; sv[q] = *(const u32x4*)(SSD_SB(rbase) + (__umul24(SSD_TL(l), (unsigned)(DSSD * 2)) + (unsigned)((head * HD + ch * 8) * 2))); }
                SSD_PHASE_F();
#pragma unroll
                for (int q = 0; q < 4; ++q) { const int e = tt + 256 * q, l = e >> 3, ch = e & 7;
                    const u32x4 yv = *(LAS u32x4*)(YST + l * 128 + ch * 16), s4 = sv[q]; u32x4 o;
                    o.x = pk2(fadd1(bf2f(yv.x & 0xffffu), bf2f(s4.x & 0xffffu)), fadd1(bf2f_hi(yv.x), bf2f_hi(s4.x))); o.y = pk2(fadd1(bf2f(yv.y & 0xffffu), bf2f(s4.y & 0xffffu)), fadd1(bf2f_hi(yv.y), bf2f_hi(s4.y)));
                    o.z = pk2(fadd1(bf2f(yv.z & 0xffffu), bf2f(s4.z & 0xffffu)), fadd1(bf2f_hi(yv.z), bf2f_hi(s4.z))); o.w = pk2(fadd1(bf2f(yv.w & 0xffffu), bf2f(s4.w & 0xffffu)), fadd1(bf2f_hi(yv.w), bf2f_hi(s4.w)));
                    sv[q] = o; }
#pragma unroll
                for (int q = 0; q < 4; ++q) { const int e = tt + 256 * q, l = e >> 3, ch = e & 7;
                    bf16_t* sp_ = (bf16_t*)(SSD_SB(rbase) + (__umul24(SSD_TL(l), (unsigned)(DSSD * 2)) + (unsigned)((head * HD + ch * 8) * 2)));
                    if (k == 1) ST16_WT(sp_, sv[q]);
                    else *(u32x4*)sp_ = sv[q]; }
            }
#undef SSD_PHASE_F
            if (k == 1) cnt_signal_wt((unsigned*)(p.ws + WS_CTL) + CW_CTXDONE, p.wv);
        }
    }
#undef SSD_RELANE
#undef SSD_TILE_BASES
#undef SSD_BASE
#undef SSD_ROW
#undef SSD_TL
#undef SSD_PB
#undef SSD_SB
#undef SSD_LD_B
#undef SSD_ST_B
#undef SSD_LD_X
#undef SSD_ST_X
#undef SSD_ST_XW
#undef SSD_LD_C
#undef SSD_LD_DT
#undef SSD_TABLES
}

}

__device__ __forceinline__ void ph_gnorm(const Params& p, int layer, int row_lo, int row_hi, int bid, int G) {
    const int tid = TIDX, lane = tid & 63; const int gw = bid * 8 + (tid >> 6), NGW = G * 8;
    bf16_t* proj = (bf16_t*)(p.ws + WS_PROJ); const float* nw = p.ssd_norm_w + layer * DSSD;
    const bf16_t* ysum = (const bf16_t*)(p.ws + WS_STASH);
    constexpr int RB = 3;
    if (bid < 0) return;
    for (int r0 = row_lo + gw * RB; r0 < row_hi; r0 += NGW * RB) {
        u32x4 v[RB][3]; float gs[RB][4];
        f32x4 wv[3][2];
#pragma unroll
        for (int j = 0; j < 3; ++j) { wv[j][0] = *(const f32x4*)(nw + (lane + 64 * j) * 8); wv[j][1] = *(const f32x4*)(nw + (lane + 64 * j) * 8 + 4); }
#pragma unroll
        for (int u = 0; u < RB; ++u)
#pragma unroll
            for (int j = 0; j < 3; ++j) { const size_t rw = (size_t)(r0 + u < row_hi ? r0 + u : row_hi - 1);
                const u32x4 y = *(const u32x4*)(ysum + rw * DSSD + (lane + 64 * j) * 8), z = *(const u32x4*)(proj + rw * PJ + PJ_ZS + (lane + 64 * j) * 8);
                u32x4 gq;
                gq.x = pk2(bf2f(y.x & 0xffffu) * silu_f(bf2f(z.x & 0xffffu)), bf2f_hi(y.x) * silu_f(bf2f_hi(z.x))); gq.y = pk2(bf2f(y.y & 0xffffu) * silu_f(bf2f(z.y & 0xffffu)), bf2f_hi(y.y) * silu_f(bf2f_hi(z.y)));
                gq.z = pk2(bf2f(y.z & 0xffffu) * silu_f(bf2f(z.z & 0xffffu)), bf2f_hi(y.z) * silu_f(bf2f_hi(z.z))); gq.w = pk2(bf2f(y.w & 0xffffu) * silu_f(bf2f(z.w & 0xffffu)), bf2f_hi(y.w) * silu_f(bf2f_hi(z.w)));
                v[u][j] = gq; }
#pragma unroll
        for (int u = 0; u < RB; ++u) { float ss[3];
#pragma unroll
            for (int j = 0; j < 3; ++j) { const unsigned w4[4] = {v[u][j].x, v[u][j].y, v[u][j].z, v[u][j].w}; float a = 0.f;
#pragma unroll
                for (int e = 0; e < 4; ++e) { const float lo = bf2f(w4[e] & 0xffffu), hi = bf2f_hi(w4[e]); a += lo * lo + hi * hi; }
                ss[j] = a; }
#pragma unroll
            for (int g = 0; g < 4; ++g) { float a = 0.f;
#pragma unroll
                for (int j = 0; j < 3; ++j) { const int c = lane + 64 * j; a += (c / 48 == g) ? ss[j] : 0.f; }
                gs[u][g] = a; } }
#pragma unroll
        for (int o = 1; o < 64; o <<= 1) {
#pragma unroll
            for (int u = 0; u < RB; ++u)
#pragma unroll
                for (int g = 0; g < 4; ++g) gs[u][g] += shx(gs[u][g], o, lane); }
#pragma unroll
        for (int u = 0; u < RB; ++u) {
#pragma unroll
            for (int g = 0; g < 4; ++g) gs[u][g] = rsqrtf(gs[u][g] * (1.f / 384.f) + EPS);
#pragma unroll
            for (int j = 0; j < 3; ++j) { const int c = lane + 64 * j, g = c / 48; const float rinv = g == 0 ? gs[u][0] : (g == 1 ? gs[u][1] : (g == 2 ? gs[u][2] : gs[u][3]));
                const f32x4 w0 = wv[j][0], w1 = wv[j][1]; u32x4 o;
                o.x = pk2(bf2f(v[u][j].x & 0xffffu) * rinv * w0[0], bf2f_hi(v[u][j].x) * rinv * w0[1]); o.y = pk2(bf2f(v[u][j].y & 0xffffu) * rinv * w0[2], bf2f_hi(v[u][j].y) * rinv * w0[3]);
                o.z = pk2(bf2f(v[u][j].z & 0xffffu) * rinv * w1[0], bf2f_hi(v[u][j].z) * rinv * w1[1]); o.w = pk2(bf2f(v[u][j].w & 0xffffu) * rinv * w1[2], bf2f_hi(v[u][j].w) * rinv * w1[3]);
                if (r0 + u < row_hi) *(u32x4*)(proj + (size_t)(r0 + u) * PJ + PJ_ZS + c * 8) = o; } }
    }
}

__device__ __forceinline__ void ph_final(const Params& p, int bid, int G) {
    const int lane = TIDX & 63; const int gw = bid * 8 + (TIDX >> 6), NGW = G * 8;
    f32x4 w[4];
#pragma unroll
    for (int j = 0; j < 4; ++j) w[j] = *(const f32x4*)(p.final_norm_w + j * 256 + lane * 4);
    constexpr int RB = 2;
    for (int row = gw * RB; row < MLAT; row += NGW * RB) {
        float* src = p.out + (size_t)row * DM;
        f32x4 v[RB][4]; float ss[RB];
#pragma unroll
        for (int u = 0; u < RB; ++u)
#pragma unroll
            for (int j = 0; j < 4; ++j) v[u][j] = *(const f32x4*)(src + (size_t)u * DM + j * 256 + lane * 4);
#pragma unroll
        for (int u = 0; u < RB; ++u) { float a = 0.f;
#pragma unroll
            for (int j = 0; j < 4; ++j) a += v[u][j].x * v[u][j].x + v[u][j].y * v[u][j].y + v[u][j].z * v[u][j].z + v[u][j].w * v[u][j].w;
            ss[u] = a; }
#pragma unroll
        for (int o = 1; o < 64; o <<= 1) {
#pragma unroll
            for (int u = 0; u < RB; ++u) ss[u] += shx(ss[u], o, lane); }
#pragma unroll
        for (int u = 0; u < RB; ++u) { const float rinv = rsqrtf(ss[u] * (1.f / DM) + EPS);
#pragma unroll
            for (int j = 0; j < 4; ++j)
                *(f32x4*)(src + (size_t)u * DM + j * 256 + lane * 4) = (f32x4){v[u][j].x * rinv * w[j].x, v[u][j].y * rinv * w[j].y, v[u][j].z * rinv * w[j].z, v[u][j].w * rinv * w[j].w}; }
    }
}


#define XB_TMO      128
#define XB_XCNT(j)  (256  + 64 * (j))
#define XB_XSUB(j)  (1280 + 64 * (j))
#define XB_XGEN(j)  (2304 + 64 * (j))
#define XB_TOP      3328
#define XB_TOPGEN   3392
#define XCD_BAR_WORDS 3456
#define XB_SPIN_CAP (1u << 18)
__device__ __forceinline__ unsigned xb_ld(unsigned* p)              { return __hip_atomic_load(p, __ATOMIC_RELAXED, __HIP_MEMORY_SCOPE_AGENT); }
__device__ __forceinline__ unsigned xb_add(unsigned* p, unsigned v) { return __hip_atomic_fetch_add(p, v, __ATOMIC_RELAXED, __HIP_MEMORY_SCOPE_AGENT); }
__device__ __forceinline__ unsigned xb_xcc_id() { return (unsigned)__builtin_amdgcn_s_getreg((3 << 11) | 20) & 0xFu; }
#define XB_SPIN(cond, bar) do { unsigned _sp = 0; while (cond) { __builtin_amdgcn_s_sleep(1); \
    if ((++_sp & 255u) == 0u) { if (xb_ld(&(bar)[XB_TMO])) break; if (_sp > XB_SPIN_CAP) { atomicAdd(&(bar)[XB_TMO], 1u); break; } } } } while (0)
struct XcdBarrier { unsigned* bar; unsigned x; volatile __attribute__((address_space(3))) unsigned* st; int wv; };
__device__ __forceinline__ XcdBarrier xcd_barrier_post(unsigned* bar, volatile __attribute__((address_space(3))) unsigned* st, int wv) {
    XcdBarrier b; b.bar = bar; b.x = xb_xcc_id(); b.st = st; b.wv = wv;
    if (wv == 0 && lane_id() == 0) (void)xb_add(&bar[XB_XCNT(b.x)], 1u);
    return b;
}
__device__ __forceinline__ void xcd_barrier_complete(unsigned* bar, unsigned x, unsigned& nloc, unsigned& nx) {
    const unsigned G = gridDim.x * gridDim.y * gridDim.z;
    unsigned sum, cnt, mine, sp = 0u;
    for (;;) {
        sum = 0u; cnt = 0u; mine = 0u;
#pragma unroll
        for (unsigned j = 0; j < 16; ++j) { const unsigned c = xb_ld(&bar[XB_XCNT(j)]); sum += c; cnt += (c > 0u) ? 1u : 0u; mine = (j == x) ? c : mine; }
        if (sum == G) break;
        __builtin_amdgcn_s_sleep(1);
        if ((++sp & 255u) == 0u) { if (xb_ld(&bar[XB_TMO])) break; if (sp > XB_SPIN_CAP) { atomicAdd(&bar[XB_TMO], 1u); break; } }
    }
    nloc = mine > 0u ? mine : 1u; nx = cnt > 0u ? cnt : 1u;
}
__device__ __forceinline__ void xcd_barrier(const XcdBarrier& b) {
    asm volatile("s_waitcnt vmcnt(0)" ::: "memory");
    __syncthreads();
    if (b.wv == 0 && lane_id() == 0) {
        unsigned* bar = b.bar;
        __builtin_amdgcn_s_waitcnt(0);
        unsigned nloc = b.st[0], nx = b.st[1];
        if (nloc == 0u) { xcd_barrier_complete(bar, b.x, nloc, nx); b.st[0] = nloc; b.st[1] = nx; }
        const unsigned old = xb_add(&bar[XB_XSUB(b.x)], 1u);
        const unsigned gen = old / nloc;
        if (old + 1u == (gen + 1u) * nloc) {
            __builtin_amdgcn_fence(__ATOMIC_RELEASE, "agent");
            asm volatile("s_waitcnt vmcnt(0)" ::: "memory");
            const unsigned og = xb_add(&bar[XB_TOP], 1u);
            const unsigned tg = og / nx;
            if (og + 1u == (tg + 1u) * nx) xb_add(&bar[XB_TOPGEN], 1u);
            else XB_SPIN(xb_ld(&bar[XB_TOPGEN]) == tg, bar);
            __builtin_amdgcn_fence(__ATOMIC_ACQUIRE, "agent");
            xb_add(&bar[XB_XGEN(b.x)], 1u);
            asm volatile("s_waitcnt vmcnt(0)" ::: "memory");
        } else {
            XB_SPIN(xb_ld(&bar[XB_XGEN(b.x)]) == gen, bar);
            __builtin_amdgcn_fence(__ATOMIC_ACQUIRE, "agent");
            asm volatile("s_waitcnt vmcnt(0)" ::: "memory");
        }
    }
    __syncthreads();
}

constexpr int NSUB = 6;
constexpr int NPHASE = 2 + NSUB * DEPTH;
__global__ void __launch_bounds__(NT, 2) mega(Params p) {
    extern __shared__ __attribute__((aligned(16))) unsigned char smem[];
    cg::grid_group grid = cg::this_grid();
    const int bid = blockIdx.x, G = gridDim.x;
    volatile __attribute__((address_space(3))) unsigned* lds_st = (volatile __attribute__((address_space(3))) unsigned*)((__attribute__((address_space(3))) unsigned char*)smem + LDS_BYTES - 64);
    const int wv = __builtin_amdgcn_readfirstlane((int)threadIdx.x >> 6);
    if (wv == 0 && lane_id() < 16) lds_st[lane_id()] = 0u;
    __syncthreads();
    const XcdBarrier xbar = xcd_barrier_post((unsigned*)(p.ws + WS_CTL), lds_st, wv);
    const bool fuse = __builtin_amdgcn_readfirstlane(p.fuse_final) != 0;
    for (int ph = p.ph_lo; ph < p.ph_hi; ++ph) {
        Params q = p; q.wv = wv;
#define fgemm_all(...) fgemm_all_(q.wv, __VA_ARGS__)
        unsigned char* ws = q.ws;
        bf16_t* H = (bf16_t*)(ws + WS_H); bf16_t* PQ = H; bf16_t* PROJ = (bf16_t*)(ws + WS_PROJ); bf16_t* UT = (bf16_t*)(ws + WS_UT); float* DT = (float*)(ws + WS_DT);
        bf16_t* W1 = (bf16_t*)(ws + WS_W1); bf16_t* WU = (bf16_t*)(ws + WS_WU); bf16_t* WO = (bf16_t*)(ws + WS_WO); bf16_t* WF = (bf16_t*)(ws + WS_WF);
        bf16_t* DFT = (bf16_t*)(ws + WS_DFT); bf16_t* DFTC = (bf16_t*)(ws + WS_DFTC);
        float* XC = (float*)(ws + WS_XC); const float* MOD = (const float*)(ws + WS_MOD);
        if (ph == 0) { ph_mod(q, smem, bid, G); ph_dftgen(q, (bid + G - 192) % G, G); ph_convert(q, smem, 0, 5, (bid + 144) % G, G); }
        else if (ph == NPHASE - 1) { ph_final(q, bid, G); }
        else {
            const int i = (ph - 1) / NSUB, sub = (ph - 1) % NSUB;
            if (sub == 0 && i > 0 && fuse) continue;
            if (sub == 0) { ph_norm(q, i, bid, G); }
            else if (sub == 1) {
                int first = fgemm_all(smem, H, DM, W1, DM, MTOT, N1, DM, pg8::EpiProj{PROJ, DT}, 0, bid, G);
                fgemm_all(smem, WU, DM, H, DM, 512, MTOT, DM, pg8::EpiUt{UT}, first, bid, G);
                if (G == 256) ph_convert(q, smem, i, 2, bid >= 232 ? bid - 232 : -1, 24);
            } else if (sub == 2) {
                ph_conv(q, smem, i, 0, 16 * 80, bid, G);
                if (G != 256) ph_convert(q, smem, i, 2, bid, G);
                if (i + 1 < DEPTH) ph_convert(q, smem, i + 1, 1, (bid + G - 128) % G, G);
            } else if (sub == 3) {
                const int nI = NB * NH;
                ssd::ph_ssd(q, smem, i, bid, G);
                { const int cb_ = G > nI ? bid - nI : bid, cg_ = G > nI ? G - nI : G;
                  if (cb_ >= 0) {
                      int first = fgemm_all(smem, DFT, SEQ, UT, SEQ, SEQ, NB * 512, SEQ, pg8::EpiPQ{PQ, 0, SEQ, 0.00276213586f  }, 0, cb_, cg_);
                      fgemm_all(smem, DFTC, CTXL, UT + (size_t)NB * 512 * SEQ, CTXL, CTXL, NB * 512, CTXL, pg8::EpiPQ{PQ, MLAT, CTXL, 0.0078125f  }, cg_ >= 64 ? 32 : first, cb_, cg_);
                      ph_dft_row0(q, cb_ * 8 + q.wv, cg_ * 8);
                      if (i + 1 < DEPTH && G > nI) {
                          unsigned* ctl = (unsigned*)(q.ws + WS_CTL);
                          cnt_signal(ctl + CW_IDLE, q.wv);
                          if (cg_ >= 64) ph_convert(q, smem, i + 1, 4, cb_ >= 16 ? cb_ - 16 : -1, cg_ - 16); else ph_convert(q, smem, i + 1, 4, cb_, cg_);
                          cnt_wait(ctl + CW_IDLE, (unsigned)(cg_ * (i + 1)), q.wv);
                          fgemm_all(smem, PQ, 1024, WF + (size_t)(i & 1) * 512 * 1024, 1024, MCTX, 512, 1024, pg8::EpiFl{PROJ, q.b_fourier + i * 512}, 0, cb_, cg_, MLAT);
                          cnt_wait(ctl + CW_CTXDONE, (unsigned)(nI * (i + 1)), q.wv);
                          ph_gnorm(q, i, MLAT, MTOT, (cb_ + cg_ - 16) % cg_, cg_);
                      }
                  } }
            }
            else if (sub == 4) {
                if (i + 1 < DEPTH && G <= NB * NH) {
                    ph_convert(q, smem, i + 1, 4, bid, G);
                    fgemm_all(smem, PQ, 1024, WF + (size_t)(i & 1) * 512 * 1024, 1024, MCTX, 512, 1024, pg8::EpiFl{PROJ, q.b_fourier + i * 512}, 0, bid, G, MLAT);
                    ph_gnorm(q, i, MLAT, MTOT, bid, G);
                    xcd_barrier(xbar);
                }
                const int nctx = (i + 1 < DEPTH) ? (MCTX / 256) * (DM / 256) : 0;
                const bool k2 = fuse && nctx > 0 && 2 * nctx + (MLAT / 256) * 2 <= G;
                const int nob = k2 ? 2 * nctx : nctx;
                const bool split = nctx > 0 && nob < G;
                const int ob = split ? (bid < nob ? bid : -1) : bid, og = split ? nctx : G;
                const int lb_ = split ? (bid >= nob ? bid - nob : -1) : bid, lg = split ? G - nob : G;
                if (nctx > 0) {
                    if (k2) {
                        if (ob >= 0 && ob < nctx)
                            fgemm_all(smem, PROJ, PJ, WO, 2048, MCTX, DM, 1024, pg8::EpiPart{(float*)(ws + WS_PART), (unsigned*)(ws + WS_CTL) + CW_PARTK}, 0, ob, og, MLAT);
                        else if (ob >= nctx)
                            fgemm_all(smem, PROJ + 1024, PJ, WO + 1024, 2048, MCTX, DM, 1024, pg8::EpiOutNormK2{{i == 0 ? q.x : q.out, q.out, i == 0 ? q.ctx : XC, XC, MOD + (size_t)i * 9 * 3072,
                                q.norm_w + (i + 1) * DM, MOD + (size_t)(i + 1) * 9 * 3072, H, (float*)(ws + WS_RSQ), (unsigned*)(ws + WS_CTL) + CW_PANEL, 4u * (unsigned)(i + 1)},
                                (const float*)(ws + WS_PART), (unsigned*)(ws + WS_CTL) + CW_PARTK, (unsigned)(i + 1)}, 0, ob - nctx, og, MLAT);
                    } else if (fuse) fgemm_all(smem, PROJ, PJ, WO, 2048, MCTX, DM, 2048, pg8::EpiOutNorm{i == 0 ? q.x : q.out, q.out, i == 0 ? q.ctx : XC, XC, MOD + (size_t)i * 9 * 3072,
                        q.norm_w + (i + 1) * DM, MOD + (size_t)(i + 1) * 9 * 3072, H, (float*)(ws + WS_RSQ), (unsigned*)(ws + WS_CTL) + CW_PANEL, 4u * (unsigned)(i + 1)}, 0, ob, og, MLAT);
                    else fgemm_all(smem, PROJ, PJ, WO, 2048, MCTX, DM, 2048, pg8::EpiOut{i == 0 ? q.x : q.out, q.out, i == 0 ? q.ctx : XC, XC, MOD + (size_t)i * 9 * 3072}, 0, ob, og, MLAT); }
                fgemm_all(smem, PQ, 1024, WF + (size_t)(i & 1) * 512 * 1024, 1024, MLAT, 512, 1024, pg8::EpiFl{PROJ, q.b_fourier + i * 512}, 0, lb_, lg, 0);
                {
                  constexpr int nfl = (MLAT / 256) * (512 / 256);
                  if (G == 256 && lg > nfl) { const int na = lg - nfl, ra = na * 24 * (na >= 128 ? 5 : 7);
                      if (lb_ >= nfl) ph_gnorm(q, i, 0, ra, lb_ - nfl, na); else if (lb_ >= 0) ph_gnorm(q, i, ra, MLAT, lb_, nfl); }
                  else ph_gnorm(q, i, 0, MLAT, lb_ < 0 ? -1 : (lb_ + lg - 128 % lg) % lg, lg); }
            } else {
                if (i + 1 == DEPTH && fuse)
                    fgemm_all(smem, PROJ, PJ, WO, 2048, MLAT, DM, 2048, pg8::EpiOutFin{q.out, q.out, MOD + (size_t)i * 9 * 3072, q.final_norm_w, (float*)(ws + WS_RSQ), (unsigned*)(ws + WS_CTL) + CW_PANEL, 4u * (unsigned)(i + 1)}, 0, bid, G, 0);
                else if (fuse)
                    fgemm_all(smem, PROJ, PJ, WO, 2048, MLAT, DM, 2048, pg8::EpiOutNorm{i == 0 ? q.x : q.out, q.out, i == 0 ? q.ctx : XC, XC, MOD + (size_t)i * 9 * 3072,
                        q.norm_w + (i + 1) * DM, MOD + (size_t)(i + 1) * 9 * 3072, H, (float*)(ws + WS_RSQ), (unsigned*)(ws + WS_CTL) + CW_PANEL, 4u * (unsigned)(i + 1)}, 0, bid, G, 0);
                else
                fgemm_all(smem, PROJ, PJ, WO, 2048, MLAT, DM, 2048, pg8::EpiOut{i == 0 ? q.x : q.out, q.out, i == 0 ? q.ctx : XC, XC, MOD + (size_t)i * 9 * 3072}, 0, bid, G, 0);
            }
        }
        if (ph + 1 < p.ph_hi) { if (ph == p.ph_lo) grid.sync(); else xcd_barrier(xbar); }
    }
}

#undef fgemm_all
extern "C" void kernel_launch(void* const* d_in, const int* in_sizes, int n_in, void* d_out, int out_size, void* d_ws, size_t ws_size, hipStream_t stream) {
    static int grid = 0;
    if (grid == 0) {
        if (n_in != 18 || ws_size < WS_END || out_size != MLAT * DM) { fprintf(stderr, "kernel_launch: unexpected shapes (n_in %d, ws %zu need %zu, out %d)\n", n_in, ws_size, (size_t)WS_END, out_size); grid = -1; return; }
        int dev = 0, cus = 0, per_cu = 0;
        (void)hipGetDevice(&dev); (void)hipDeviceGetAttribute(&cus, hipDeviceAttributeMultiprocessorCount, dev);
        if (hipFuncSetAttribute((const void*)mega, hipFuncAttributeMaxDynamicSharedMemorySize, LDS_BYTES) != hipSuccess) { fprintf(stderr, "kernel_launch: hipFuncSetAttribute failed\n"); grid = -1; return; }
        if (hipOccupancyMaxActiveBlocksPerMultiprocessor(&per_cu, (const void*)mega, NT, LDS_BYTES) != hipSuccess || per_cu < 1) { fprintf(stderr, "kernel_launch: occupancy query says %d\n", per_cu); grid = -1; return; }
        grid = cus;
    }
    if (grid < 0) return;
    Params p{};
    const float** f = (const float**)&p;
    for (int i = 0; i < 18; ++i) f[i] = (const float*)d_in[i];
    p.out = (float*)d_out; p.ws = (unsigned char*)d_ws; p.ph_lo = 0;
    p.fuse_final = (DEPTH > 1 && grid >= (MLAT / 256) * (DM / 256)) ? 1 : 0;
    p.ph_hi = NPHASE - p.fuse_final;
    if (hipMemsetAsync((char*)d_ws + WS_CTL, 0, 65536, stream) != hipSuccess) { fprintf(stderr, "kernel_launch: memset of control words failed\n"); return; }
    void* args[] = {&p};
    hipError_t e = hipLaunchCooperativeKernel((const void*)mega, dim3(grid), dim3(NT), args, LDS_BYTES, stream);
    if (e != hipSuccess) fprintf(stderr, "kernel_launch: cooperative launch failed: %s (grid %d)\n", hipGetErrorString(e), grid);
}
```
